# Optimizing an MI355X kernel written in HIP

```python
import math
import jax
import jax.numpy as jnp
from jax import lax
import numpy as np

D_MODEL = 1024
BATCH = 32
SEQ = 256
DEPTH = 2
DEC_BATCH = 4
DEC_SEQ = 4096
PAST_LEN = 256

GRID_W = 64
D_MIX = D_MODEL
D_RNN = D_MIX // 2
D_HY = D_MIX - D_RNN
N_RNN_HEADS = 8
RNN_HEAD_DIM = D_RNN // N_RNN_HEADS
RG_CONV_W = 4
RG_C = 8.0
HY_CONV_W = 3
HY_ORDER = 2
HY_BANDS = 16
HY_EMB = 1 + 2 * HY_BANDS
HY_FH = 64
HY_DECAY_TARGET = 1e-2
HY_DECAY_PCT_SHORT = 0.3
HY_DECAY_PCT_LONG = 1.5
D_FF = ((8 * D_MODEL // 3 + 127) // 128) * 128
FFN_CONV_W = 3
D_IN = 2 * D_RNN + 3 * D_HY
N_MOD = 6
EPS = 1e-6

kernel_name = 'hymba_rglru_hyena_prefix_dit_step'


def rms_norm(x, g):
    x32 = x.astype(jnp.float32)
    y = x32 * lax.rsqrt(jnp.mean(x32 * x32, axis=-1, keepdims=True) + EPS)
    return y.astype(x.dtype) * g


def dwconv1d(x, w, b):
    K = w.shape[0]
    L = x.shape[1]
    left = K // 2
    xp = jnp.pad(x, ((0, 0), (left, K - 1 - left), (0, 0)))
    out = xp[:, 0:L] * w[0]
    for k in range(1, K):
        out = out + xp[:, k:k + L] * w[k]
    return out + b


def dwconv2d_grid(x, w, b):
    B, L, C = x.shape
    rows = L // GRID_W
    xg = x.reshape(B, rows, GRID_W, C)
    y = lax.conv_general_dilated(xg, w[:, :, None, :], window_strides=(1, 1), padding='SAME',
                                 dimension_numbers=('NHWC', 'HWIO', 'NHWC'), feature_group_count=C)
    return y.reshape(B, L, C) + b


def _lin_combine(e1, e2):
    a1, b1 = e1
    a2, b2 = e2
    return a1 * a2, a2 * b1 + b2


def rglru(x, h0, gate_w, gate_b, a_param, reverse):
    B, L, _ = x.shape
    x32 = x.astype(jnp.float32)
    xh = x32.reshape(B, L, N_RNN_HEADS, RNN_HEAD_DIM)
    g = jnp.einsum('blhi,ghij->gblhj', xh, gate_w.astype(jnp.float32)).reshape(2, B, L, D_RNN)
    g = g + gate_b.astype(jnp.float32)[:, None, None, :]
    r = jax.nn.sigmoid(g[0])
    i = jax.nn.sigmoid(g[1])
    log_a = -RG_C * r * jax.nn.softplus(-a_param.astype(jnp.float32))
    a = jnp.exp(log_a)
    b = x32 * i * jnp.sqrt(-jnp.expm1(2.0 * log_a))
    A, Bc = lax.associative_scan(_lin_combine, (a, b), reverse=reverse, axis=1)
    return A * h0.astype(jnp.float32)[:, None, :] + Bc


def hyena_filter_fft(L, w1, b1, w2, b2, w3, freq):
    f32 = jnp.float32
    pos = jnp.arange(L, dtype=f32)
    t = pos / max(L - 1, 1)
    omega = 2.0 * math.pi * pos / L
    bands = jnp.linspace(1e-4, HY_BANDS - 1, HY_BANDS, dtype=f32)
    ang = omega[:, None] * bands[None, :]
    feats = jnp.concatenate([t[:, None], jnp.cos(ang), jnp.sin(ang)], axis=-1)
    fr = freq.astype(f32)
    h = jnp.sin(fr[0] * (feats @ w1.astype(f32) + b1.astype(f32)))
    h = jnp.sin(fr[1] * (h @ w2.astype(f32) + b2.astype(f32)))
    h = (h @ w3.astype(f32)).reshape(L, HY_ORDER, 2, D_HY)
    min_decay = math.log(HY_DECAY_TARGET) / HY_DECAY_PCT_LONG
    max_decay = math.log(HY_DECAY_TARGET) / HY_DECAY_PCT_SHORT
    deltas = jnp.abs(jnp.linspace(min_decay, max_decay, D_HY, dtype=f32))
    h = h * jnp.exp(-t[:, None] * deltas[None, :])[:, None, None, :]
    h_fwd = h[:, :, 0]
    h_bwd = h[:, :, 1]
    circ = jnp.concatenate([h_fwd, jnp.zeros((1, HY_ORDER, D_HY), f32), h_bwd[:0:-1]], axis=0)
    return jnp.fft.rfft(circ, axis=0)


def fft_long_conv(u, k_f, bias):
    L = u.shape[1]
    U = jnp.fft.rfft(u, n=2 * L, axis=1)
    y = jnp.fft.irfft(U * k_f[None], n=2 * L, axis=1)[:, :L]
    return y + u * bias.astype(jnp.float32)


def trunk_layer(x, mod, h0_f, h0_b, p, on_grid):
    shift1, scale1, gate1, shift2, scale2, gate2 = jnp.split(mod[:, None, :], N_MOD, axis=-1)
    xn = rms_norm(x, p['g_norm1']) * (1 + scale1) + shift1
    proj = xn @ p['w_in']
    x_r = proj[..., :D_RNN]
    y_r = proj[..., D_RNN:2 * D_RNN]
    hy_in = proj[..., 2 * D_RNN:]
    xc = dwconv1d(x_r, p['rg_conv_w'], p['rg_conv_b'])
    h_f = rglru(xc, h0_f, p['rg_gate_w'][0], p['rg_gate_b'][0], p['rg_a'][0], False)
    h_b = rglru(xc, h0_b, p['rg_gate_w'][1], p['rg_gate_b'][1], p['rg_a'][1], True)
    o_r = ((h_f + h_b) * jax.nn.gelu(y_r.astype(jnp.float32))).astype(x.dtype)
    hy = dwconv1d(hy_in, p['hy_conv_w'], p['hy_conv_b']).astype(jnp.float32)
    v, x1, x2 = jnp.split(hy, 3, axis=-1)
    k_f = hyena_filter_fft(x.shape[1], p['hf_w1'], p['hf_b1'], p['hf_w2'], p['hf_b2'], p['hf_w3'], p['hf_freq'])
    z = x1 * fft_long_conv(v, k_f[:, 0], p['hy_bias'][0])
    z = x2 * fft_long_conv(z, k_f[:, 1], p['hy_bias'][1])
    o_h = z.astype(x.dtype)
    o = jnp.concatenate([rms_norm(o_r, p['g_rnn_out']), rms_norm(o_h, p['g_hy_out'])], axis=-1) @ p['w_out']
    x = x + gate1 * o
    xn2 = rms_norm(x, p['g_norm2']) * (1 + scale2) + shift2
    a_ff, g_ff = jnp.split(xn2 @ p['w_up'], 2, axis=-1)
    if on_grid:
        g_ff = dwconv2d_grid(g_ff, p['ffn_conv_w'], p['ffn_conv_b'])
    else:
        g_ff = dwconv1d(g_ff, p['ffn_conv_w'][1], p['ffn_conv_b'])
    x = x + gate2 * ((jax.nn.gelu(g_ff) * a_ff) @ p['w_down'])
    return x, h_f[:, -1], h_b[:, 0]


def setup_inputs(seed: int = 0) -> dict:
    key = jax.random.key(seed)
    ks = iter(jax.random.split(key, 48))

    def nrm(shape, scale):
        return scale * jax.random.normal(next(ks), shape, jnp.float32)

    x_prompt = nrm((BATCH, SEQ, D_MODEL), 1.0)
    x_sample = nrm((DEC_BATCH, DEC_SEQ, D_MODEL), 1.0)
    state_rglru = nrm((DEC_BATCH, DEPTH, 2, D_RNN), 0.5)
    c = nrm((DEC_BATCH, D_MODEL), 1.0)
    c_ctx = nrm((D_MODEL,), 1.0)
    w_ada = nrm((DEPTH, D_MODEL, N_MOD * D_MODEL), 0.5 * D_MODEL ** -0.5)
    b_ada = nrm((DEPTH, N_MOD * D_MODEL), 0.02)
    g_norm1 = 1.0 + nrm((DEPTH, D_MODEL), 0.02)
    g_norm2 = 1.0 + nrm((DEPTH, D_MODEL), 0.02)
    w_in = nrm((DEPTH, D_MODEL, D_IN), D_MODEL ** -0.5)
    rg_conv_w = nrm((DEPTH, RG_CONV_W, D_RNN), RG_CONV_W ** -0.5)
    rg_conv_b = nrm((DEPTH, D_RNN), 0.02)
    rg_gate_w = nrm((DEPTH, 2, 2, N_RNN_HEADS, RNN_HEAD_DIM, RNN_HEAD_DIM), RNN_HEAD_DIM ** -0.5)
    rg_gate_b = nrm((DEPTH, 2, 2, D_RNN), 0.02)
    u = jax.random.uniform(next(ks), (DEPTH, 2, D_RNN), jnp.float32, 0.9, 0.999)
    a_base = u ** (1.0 / RG_C)
    rg_a = jnp.log(a_base) - jnp.log1p(-a_base)
    hy_conv_w = nrm((DEPTH, HY_CONV_W, 3 * D_HY), HY_CONV_W ** -0.5)
    hy_conv_b = nrm((DEPTH, 3 * D_HY), 0.02)
    hf_w1 = nrm((DEPTH, HY_EMB, HY_FH), HY_EMB ** -0.5)
    hf_b1 = nrm((DEPTH, HY_FH), 0.1)
    hf_w2 = nrm((DEPTH, HY_FH, HY_FH), HY_FH ** -0.5)
    hf_b2 = nrm((DEPTH, HY_FH), 0.1)
    hf_w3 = nrm((DEPTH, HY_FH, HY_ORDER * 2 * D_HY), HY_FH ** -0.5)
    hf_freq = 1.0 + nrm((DEPTH, 2, HY_FH), 0.1)
    hy_bias = nrm((DEPTH, HY_ORDER, D_HY), 0.5)
    g_rnn_out = 1.0 + nrm((DEPTH, D_RNN), 0.02)
    g_hy_out = 1.0 + nrm((DEPTH, D_HY), 0.02)
    w_out = nrm((DEPTH, D_MIX, D_MODEL), D_MIX ** -0.5)
    w_up = nrm((DEPTH, D_MODEL, 2 * D_FF), D_MODEL ** -0.5)
    ffn_conv_w = nrm((DEPTH, FFN_CONV_W, FFN_CONV_W, D_FF), 1.0 / FFN_CONV_W)
    ffn_conv_b = nrm((DEPTH, D_FF), 0.02)
    w_down = nrm((DEPTH, D_FF, D_MODEL), D_FF ** -0.5)
    g_final = 1.0 + nrm((D_MODEL,), 0.02)
    return {'x_prompt': x_prompt, 'x_sample': x_sample, 'state_rglru': state_rglru, 'c': c, 'c_ctx': c_ctx,
            'w_ada': w_ada, 'b_ada': b_ada, 'g_norm1': g_norm1, 'g_norm2': g_norm2, 'w_in': w_in,
            'rg_conv_w': rg_conv_w, 'rg_conv_b': rg_conv_b, 'rg_gate_w': rg_gate_w, 'rg_gate_b': rg_gate_b,
            'rg_a': rg_a, 'hy_conv_w': hy_conv_w, 'hy_conv_b': hy_conv_b, 'hf_w1': hf_w1, 'hf_b1': hf_b1,
            'hf_w2': hf_w2, 'hf_b2': hf_b2, 'hf_w3': hf_w3, 'hf_freq': hf_freq, 'hy_bias': hy_bias,
            'g_rnn_out': g_rnn_out, 'g_hy_out': g_hy_out, 'w_out': w_out, 'w_up': w_up,
            'ffn_conv_w': ffn_conv_w, 'ffn_conv_b': ffn_conv_b, 'w_down': w_down, 'g_final': g_final}


def reference(x_prompt, x_sample, state_rglru, c, c_ctx, w_ada, b_ada, g_norm1, g_norm2, w_in,
              rg_conv_w, rg_conv_b, rg_gate_w, rg_gate_b, rg_a, hy_conv_w, hy_conv_b, hf_w1, hf_b1,
              hf_w2, hf_b2, hf_w3, hf_freq, hy_bias, g_rnn_out, g_hy_out, w_out, w_up,
              ffn_conv_w, ffn_conv_b, w_down, g_final):
    xp = x_prompt
    xs = x_sample
    zero_h = jnp.zeros((x_prompt.shape[0], D_RNN), jnp.float32)
    new_states = []
    for l in range(DEPTH):
        p = {'g_norm1': g_norm1[l], 'g_norm2': g_norm2[l], 'w_in': w_in[l],
             'rg_conv_w': rg_conv_w[l], 'rg_conv_b': rg_conv_b[l], 'rg_gate_w': rg_gate_w[l],
             'rg_gate_b': rg_gate_b[l], 'rg_a': rg_a[l], 'hy_conv_w': hy_conv_w[l], 'hy_conv_b': hy_conv_b[l],
             'hf_w1': hf_w1[l], 'hf_b1': hf_b1[l], 'hf_w2': hf_w2[l], 'hf_b2': hf_b2[l], 'hf_w3': hf_w3[l],
             'hf_freq': hf_freq[l], 'hy_bias': hy_bias[l], 'g_rnn_out': g_rnn_out[l], 'g_hy_out': g_hy_out[l],
             'w_out': w_out[l], 'w_up': w_up[l], 'ffn_conv_w': ffn_conv_w[l], 'ffn_conv_b': ffn_conv_b[l],
             'w_down': w_down[l]}
        mod_ctx = jax.nn.silu(c_ctx)[None, :] @ w_ada[l] + b_ada[l]
        mod_lat = jax.nn.silu(c) @ w_ada[l] + b_ada[l]
        xp, hf_last, hb_first = trunk_layer(xp, mod_ctx, zero_h, zero_h, p, False)
        new_states.append(jnp.stack([hf_last, hb_first], axis=1).astype(x_prompt.dtype))
        xs, _, _ = trunk_layer(xs, mod_lat, state_rglru[:, l, 0], state_rglru[:, l, 1], p, True)
    y_prompt = rms_norm(xp, g_final)
    y_sample = rms_norm(xs, g_final)
    new_state_rglru = jnp.stack(new_states, axis=1)
    return (y_prompt, y_sample, new_state_rglru)
```

```cpp
#define PROBE_MASK 0
#include <hip/hip_runtime.h>
#include <hip/hip_cooperative_groups.h>
#include <cstdio>
namespace cg = cooperative_groups;

#define LAS __attribute__((address_space(3)))
typedef unsigned short bf16_t;
typedef short bf16x8 __attribute__((ext_vector_type(8)));
typedef float f32x4 __attribute__((ext_vector_type(4)));
typedef unsigned u32x4 __attribute__((ext_vector_type(4)));
typedef unsigned u32x2 __attribute__((ext_vector_type(2)));
typedef float v2f __attribute__((ext_vector_type(2)));

constexpr int DM = 1024, NCTX = 8192, NLAT = 16384, MTOK = 24576, DRNN = 512, DIN = 2560, DFF = 2816;
constexpr int NTHR = 512;
constexpr int FF_N0 = 1536, FF_N1 = 1280;
constexpr float EPS = 1e-6f;

constexpr size_t AL(size_t x) { return (x + 255) & ~(size_t)255; }
constexpr size_t WS_BAR  = 0;
constexpr size_t WS_BAR_BYTES = 16384;
constexpr size_t WS_SP   = WS_BAR_BYTES;
constexpr size_t WS_MOD  = AL(WS_SP + 2 * 2 * 512 * 4);
constexpr size_t WS_H2   = AL(WS_MOD + 2 * 5 * 6144 * 4);
constexpr size_t WS_H2B  = AL(WS_H2 + 2 * 4352 * 64 * 4);
constexpr size_t WS_W3T  = AL(WS_H2B + 2 * 4352 * 64 * 2);
constexpr size_t WS_GW   = AL(WS_W3T + 2 * 2048 * 64 * 2);
constexpr size_t WS_AGG  = AL(WS_GW + 131072 * 2);
constexpr size_t WS_WIN  = AL(WS_AGG + (size_t)768 * 2 * 512 * 8);
constexpr size_t WS_WOUT = AL(WS_WIN + (size_t)2560 * 1024 * 2);
constexpr size_t WS_WUP  = AL(WS_WOUT + (size_t)1024 * 1024 * 2);
constexpr size_t WS_WDN0 = AL(WS_WUP + (size_t)5632 * 1024 * 2);
constexpr size_t WS_WDN1 = AL(WS_WDN0 + (size_t)1024 * 1536 * 2);
constexpr size_t WS_XN   = AL(WS_WDN1 + (size_t)1024 * 1280 * 2);
constexpr size_t WS_BIG  = AL(WS_XN + (size_t)MTOK * 1024 * 2);
constexpr size_t WS_PRG  = WS_BIG;
constexpr size_t WS_PHY  = AL(WS_PRG + (size_t)MTOK * 1024 * 2);
constexpr size_t PHY_LAT_OFF = (size_t)32 * 1536 * 256;
constexpr size_t WS_TAPS = AL(WS_PHY + (size_t)MTOK * 1536 * 2);
constexpr size_t TAPS_LAT_OFF = (size_t)2048 * 256;
constexpr size_t WS_MIX_END = AL(WS_TAPS + ((size_t)2048 * 256 + (size_t)2048 * 4096) * 4);
constexpr size_t WS_FA   = WS_BIG;
constexpr size_t WS_FG   = AL(WS_FA + (size_t)MTOK * FF_N0 * 2);
constexpr size_t WS_FFN_END = AL(WS_FG + (size_t)MTOK * FF_N0 * 2);
constexpr size_t WS_END  = WS_MIX_END > WS_FFN_END ? WS_MIX_END : WS_FFN_END;

constexpr int LDS_BYTES = 140 * 1024;

#ifndef PROBE_MASK
#define PROBE_MASK 0
#endif
struct P {
    const float* in[32];
    float* out;
    unsigned char* ws;
    int dup_mask; int pad;
};
typedef const __attribute__((address_space(4))) P CP;
__device__ __forceinline__ CP* opq(CP* q) { asm volatile("" : "+s"(q)); return q; }
enum { I_XP = 0, I_XS, I_ST, I_C, I_CCTX, I_WADA, I_BADA, I_GN1, I_GN2, I_WIN, I_RGCW, I_RGCB, I_RGGW, I_RGGB, I_RGA, I_HYCW, I_HYCB,
       I_HFW1, I_HFB1, I_HFW2, I_HFB2, I_HFW3, I_HFFR, I_HYB, I_GRNN, I_GHY, I_WOUT, I_WUP, I_FCW, I_FCB, I_WDN, I_GFIN };

__device__ __forceinline__ float bf2f(unsigned b) { return __uint_as_float(b << 16); }
__device__ __forceinline__ unsigned f2bf(float f) { unsigned u = __float_as_uint(f); return (u + 0x7fffu + ((u >> 16) & 1u)) >> 16; }
__device__ __forceinline__ unsigned pk2(float lo, float hi) { unsigned r; asm volatile("v_cvt_pk_bf16_f32 %0, %1, %2" : "=v"(r) : "v"(lo), "v"(hi)); return r; }
__device__ __forceinline__ float sigmoidf_(float x) { return 1.0f / (1.0f + __expf(-x)); }
__device__ __forceinline__ float gelu_tanh(float x) {
    const float u = 0.7978845608028654f * (x + 0.044715f * x * x * x);
    const float e = __expf(2.0f * u);
    const float t = 1.0f - 2.0f / (1.0f + e);
    return 0.5f * x * (1.0f + t);
}
__device__ __forceinline__ float gelu_fast(float x) {
    const float x2 = x * x;
    const float t = x * (-2.302208198f - 0.1029432397f * x2);
    return x * __builtin_amdgcn_rcpf(1.0f + __builtin_amdgcn_exp2f(t));
}
__device__ __forceinline__ float wave_sum(float v) {
#pragma unroll
    for (int o = 32; o >= 1; o >>= 1) v += __shfl_xor(v, o);
    return v;
}
__device__ __forceinline__ int opaque_tid() { int t = threadIdx.x; asm volatile("" : "+v"(t)); return t; }
__device__ __forceinline__ int mod_row(int row) { return row < NCTX ? 0 : 1 + ((row - NCTX) >> 12); }

#define XB_TMO      128
#define XB_XCNT(j)  (256  + 64 * (j))
#define XB_XSUB(j)  (1280 + 64 * (j))
#define XB_XGEN(j)  (2304 + 64 * (j))
#define XB_TOP      3328
#define XB_TOPGEN   3392
#define XCD_BAR_WORDS 3456
#define XB_SPIN_CAP (1u << 18)

__device__ __forceinline__ unsigned xb_ld(unsigned* p)              { return __hip_atomic_load(p, __ATOMIC_RELAXED, __HIP_MEMORY_SCOPE_AGENT); }
__device__ __forceinline__ unsigned xb_add(unsigned* p, unsigned v) { return __hip_atomic_fetch_add(p, v, __ATOMIC_RELAXED, __HIP_MEMORY_SCOPE_AGENT); }
__device__ __forceinline__ unsigned xb_xcc_id() { return (unsigned)__builtin_amdgcn_s_getreg((3 << 11) | 20) & 0xFu; }
#define XB_SPIN(cond, bar) do { unsigned _sp = 0; while (cond) { __builtin_amdgcn_s_sleep(1); \
    if ((++_sp & 255u) == 0u) { if (xb_ld(&(bar)[XB_TMO])) break; if (_sp > XB_SPIN_CAP) { atomicAdd(&(bar)[XB_TMO], 1u); break; } } } } while (0)

struct XcdBarrier {
    unsigned* bar; unsigned x;
    volatile LAS unsigned* st;
};

__device__ __forceinline__ XcdBarrier xcd_barrier_post(unsigned* bar, volatile LAS unsigned* st) {
    XcdBarrier b; b.bar = bar; b.x = xb_xcc_id(); b.st = st;
    if (threadIdx.x == 0) (void)xb_add(&bar[XB_XCNT(b.x)], 1u);
    return b;
}
__device__ __forceinline__ void xcd_barrier_complete(unsigned* bar, unsigned x, unsigned& nloc, unsigned& nx) {
    const unsigned G = gridDim.x * gridDim.y * gridDim.z;
    unsigned sum, cnt, mine, sp = 0u;
    for (;;) {
        sum = 0u; cnt = 0u; mine = 0u;
#pragma unroll
        for (unsigned j = 0; j < 16; ++j) { const unsigned c = xb_ld(&bar[XB_XCNT(j)]); sum += c; cnt += (c > 0u) ? 1u : 0u; mine = (j == x) ? c : mine; }
        if (sum == G) break;
        __builtin_amdgcn_s_sleep(1);
        if ((++sp & 255u) == 0u) { if (xb_ld(&bar[XB_TMO])) break; if (sp > XB_SPIN_CAP) { atomicAdd(&bar[XB_TMO], 1u); break; } }
    }
    nloc = mine > 0u ? mine : 1u; nx = cnt > 0u ? cnt : 1u;
}

__device__ __forceinline__ void xcd_barrier(const XcdBarrier& b) {
    asm volatile("s_waitcnt vmcnt(0)" ::: "memory");
    __syncthreads();
    if (threadIdx.x == 0) {
        unsigned* bar = b.bar;
        __builtin_amdgcn_s_waitcnt(0);
        unsigned nloc = b.st[0], nx = b.st[1];
        if (nloc == 0u) { xcd_barrier_complete(bar, b.x, nloc, nx); b.st[0] = nloc; b.st[1] = nx; }
        const unsigned old = xb_add(&bar[XB_XSUB(b.x)], 1u);
        const unsigned gen = old / nloc;
        if (old + 1u == (gen + 1u) * nloc) {
            __builtin_amdgcn_fence(__ATOMIC_RELEASE, "agent");
            asm volatile("s_waitcnt vmcnt(0)" ::: "memory");
            const unsigned og = xb_add(&bar[XB_TOP], 1u);
            const unsigned tg = og / nx;
            if (og + 1u == (tg + 1u) * nx) xb_add(&bar[XB_TOPGEN], 1u);
            else XB_SPIN(xb_ld(&bar[XB_TOPGEN]) == tg, bar);
            __builtin_amdgcn_fence(__ATOMIC_ACQUIRE, "agent");
            xb_add(&bar[XB_XGEN(b.x)], 1u);
            asm volatile("s_waitcnt vmcnt(0)" ::: "memory");
        } else {
            XB_SPIN(xb_ld(&bar[XB_XGEN(b.x)]) == gen, bar);
            __builtin_amdgcn_fence(__ATOMIC_ACQUIRE, "agent");
            asm volatile("s_waitcnt vmcnt(0)" ::: "memory");
        }
    }
    __syncthreads();
}

namespace pg8 {
constexpr int BM = 256, BK = 64, HALF = 128, HTB = HALF * BK * 2, STAGE_BYTES = 8 * HTB, NXCD = 8, WGM = 8;
__device__ __forceinline__ int lds_byte(int r, int c) { const int st = (r >> 4) * 2 + (c >> 5), rr = r & 15, cc = c & 31, ob = rr * 64 + cc * 2; return st * 1024 + (ob ^ (((ob >> 9) & 1) << 5)); }
__device__ __forceinline__ void stage_rc(int b, int& R, int& C) { const int st = b / 1024, sb = b % 1024, swz = sb ^ (((sb >> 9) & 1) << 5); R = (st >> 1) * 16 + swz / 64; C = (st & 1) * 32 + (swz % 64) / 2; }
__device__ __forceinline__ int perm32(int rho) { const int n = rho >> 4, i = rho & 15; return 8 * (i >> 2) + 4 * n + (i & 3); }
struct Unit { int pm, pn; };
struct TileOrder {
    int nM, nN, nwg, G, c;
    __device__ void init(int nM_, int nN_, int G_, int c_) { nM = nM_; nN = nN_; nwg = nM * nN; G = G_; c = c_; }
    __device__ bool next(int i, Unit& u) const {
        const long L = (long)i * G + c; if (L >= nwg) return false;
        int wgid = (int)L; { const int q = nwg / NXCD, r = nwg % NXCD, xcd = wgid % NXCD, off = wgid / NXCD; wgid = (xcd < r ? xcd * (q + 1) : r * (q + 1) + (xcd - r) * q) + off; }
        const int nig = WGM * nN, gid = wgid / nig, fm = gid * WGM, gsz = (nM - fm) < WGM ? (nM - fm) : WGM;
        u.pm = fm + ((wgid % nig) % gsz); u.pn = (wgid % nig) / gsz; return true;
    }
};
__device__ __forceinline__ unsigned cvt_pk_bf16(float lo, float hi) { unsigned r; asm volatile("v_cvt_pk_bf16_f32 %0, %1, %2" : "=v"(r) : "v"(lo), "v"(hi)); return r; }

template <class Epi, class Sched, bool ALIGN_EPI = true, bool SP2 = true>
__device__ __forceinline__ void gemm_phase(LAS unsigned char* lds, const int K, const Sched& S, const Epi& E) {
    const int tid = opaque_tid(), wid = __builtin_amdgcn_readfirstlane(tid >> 6), lane = tid & 63, wr = wid >> 2, wc = wid & 3, fr = lane & 15, fq = lane >> 4;
    const int nt = K / BK;
    unsigned voffA[2], voffB[2];
#pragma unroll
    for (int i = 0; i < 2; ++i) { int R, C; stage_rc(tid * 16 + i * 8192, R, C); const int Rb = Epi::PERM ? ((R & ~31) + perm32(R & 31)) : R;
        voffA[i] = (unsigned)(R * K + C) * 2u; voffB[i] = (unsigned)(Rb * K + C) * 2u; }
    const size_t kstep = (size_t)(BK * 2);
    const size_t hstep = (size_t)HALF * K * 2;
    const unsigned ldsw = (unsigned)wid * 1024u;
    const int aoff = lds_byte(wr * 64 + fr, fq * 8), boff = lds_byte(wc * 32 + fr, fq * 8);
#define PG8_SA(b, h) (((b) * 2 + (h)) * HTB)
#define PG8_SB(b, h) ((4 + (b) * 2 + (h)) * HTB)
#define PG8_STAGE(bufoff, gbase, voff) do { _Pragma("unroll") for (int _i = 0; _i < 2; ++_i) \
        __builtin_amdgcn_global_load_lds((const unsigned*)((const char*)(gbase) + (voff)[_i]), (LAS unsigned*)(lds + (bufoff) + ldsw + _i * 8192), 16, 0, 0); } while (0)
#define PG8_LDA(dst, b, h) do { _Pragma("unroll") for (int m = 0; m < 4; ++m) _Pragma("unroll") for (int k = 0; k < 2; ++k) dst[m][k] = *(const LAS bf16x8*)(lds + PG8_SA(b, h) + aoff + m * 2048 + k * 1024); } while (0)
#define PG8_LDB(dst, b, h) do { _Pragma("unroll") for (int n = 0; n < 2; ++n) _Pragma("unroll") for (int k = 0; k < 2; ++k) dst[n][k] = *(const LAS bf16x8*)(lds + PG8_SB(b, h) + boff + n * 2048 + k * 1024); } while (0)
#define PG8_MMA(ai, bj, At, Bt) do { __builtin_amdgcn_s_setprio(1); _Pragma("unroll") for (int m = 0; m < 4; ++m) _Pragma("unroll") for (int n = 0; n < 2; ++n) _Pragma("unroll") for (int k = 0; k < 2; ++k) \
        acc[ai][bj][m][n] = __builtin_amdgcn_mfma_f32_16x16x32_bf16(Bt[n][k], At[m][k], acc[ai][bj][m][n], 0, 0, 0); __builtin_amdgcn_s_setprio(0); } while (0)
#define PG8_WAIT_V(n) asm volatile("s_waitcnt vmcnt(" #n ")" ::: "memory")
#define PG8_WAIT_L(n) asm volatile("s_waitcnt lgkmcnt(" #n ")" ::: "memory")
#define PG8_BAR __builtin_amdgcn_s_barrier()
#define PG8_SCHED __builtin_amdgcn_sched_barrier(0)
    Unit cur, nxt; int ui = 0;
    if (!S.next(0, cur)) return;
    f32x4 acc[2][2][4][2];
#pragma unroll
    for (int a = 0; a < 2; ++a)
#pragma unroll
        for (int b = 0; b < 2; ++b)
#pragma unroll
            for (int m = 0; m < 4; ++m)
#pragma unroll
                for (int n = 0; n < 2; ++n) acc[a][b][m][n] = (f32x4){0.f, 0.f, 0.f, 0.f};
    bf16x8 At[4][2], B0[2][2], B1[2][2];
    const char* cA = S.a_base(cur); const char* cB = S.b_base(cur);
    if constexpr (SP2) {
        PG8_STAGE(PG8_SB(0, 0), cB, voffB); PG8_STAGE(PG8_SB(0, 1), cB + hstep, voffB); PG8_STAGE(PG8_SA(0, 0), cA, voffA); PG8_STAGE(PG8_SA(0, 1), cA + hstep, voffA);
        if (wr == 1) PG8_BAR;
        PG8_WAIT_V(2); PG8_BAR;
        PG8_STAGE(PG8_SB(1, 0), cB + kstep, voffB); PG8_STAGE(PG8_SA(1, 0), cA + kstep, voffA); PG8_STAGE(PG8_SB(1, 1), cB + hstep + kstep, voffB);
        PG8_WAIT_V(6); PG8_BAR;
    } else {
        PG8_STAGE(PG8_SB(0, 0), cB, voffB); PG8_STAGE(PG8_SA(0, 0), cA, voffA); PG8_STAGE(PG8_SB(0, 1), cB + hstep, voffB); PG8_STAGE(PG8_SA(0, 1), cA + hstep, voffA);
        if (wr == 1) PG8_BAR;
        PG8_WAIT_V(4); PG8_BAR;
        PG8_STAGE(PG8_SB(1, 0), cB + kstep, voffB); PG8_STAGE(PG8_SA(1, 0), cA + kstep, voffA); PG8_STAGE(PG8_SB(1, 1), cB + hstep + kstep, voffB);
        PG8_WAIT_V(6); PG8_BAR;
    }
    for (;;) {
        const bool has_next = S.next(ui + 1, nxt);
        const char* nA = has_next ? S.a_base(nxt) : cA; const char* nB = has_next ? S.b_base(nxt) : cB;
        for (int t = 0; t < nt; t += 2) {
            const bool last = (t == nt - 2);
            const char* a1 = cA + (size_t)(t + 1) * kstep;
            const char* a2 = last ? nA : cA + (size_t)(t + 2) * kstep; const char* b2 = last ? nB : cB + (size_t)(t + 2) * kstep;
            const char* a3 = a2 + kstep; const char* b3 = b2 + kstep;
            if constexpr (SP2) {
            PG8_LDB(B0, 0, 0); PG8_LDB(B1, 0, 1); PG8_SCHED; PG8_LDA(At, 0, 0); PG8_STAGE(PG8_SA(1, 1), a1 + hstep, voffA);
            PG8_WAIT_V(8); PG8_WAIT_L(0); PG8_BAR; PG8_MMA(0, 0, At, B0); PG8_MMA(0, 1, At, B1); PG8_BAR; PG8_SCHED;
            PG8_LDA(At, 0, 1); PG8_STAGE(PG8_SB(0, 0), b2, voffB); PG8_STAGE(PG8_SB(0, 1), b2 + hstep, voffB); PG8_STAGE(PG8_SA(0, 0), a2, voffA);
            PG8_WAIT_V(8); PG8_WAIT_L(0); PG8_BAR; PG8_MMA(1, 0, At, B0); PG8_MMA(1, 1, At, B1); PG8_BAR; PG8_SCHED;
            PG8_LDB(B0, 1, 0); PG8_LDB(B1, 1, 1); PG8_SCHED; PG8_LDA(At, 1, 0); PG8_STAGE(PG8_SA(0, 1), a2 + hstep, voffA);
            PG8_WAIT_V(8); PG8_WAIT_L(0); PG8_BAR; PG8_MMA(0, 0, At, B0); PG8_MMA(0, 1, At, B1); PG8_BAR; PG8_SCHED;
            PG8_LDA(At, 1, 1); PG8_STAGE(PG8_SB(1, 0), b3, voffB); PG8_STAGE(PG8_SB(1, 1), b3 + hstep, voffB); PG8_STAGE(PG8_SA(1, 0), a3, voffA);
            PG8_WAIT_V(8); PG8_WAIT_L(0); PG8_BAR; PG8_MMA(1, 0, At, B0); PG8_MMA(1, 1, At, B1); PG8_BAR; PG8_SCHED;
            } else {
            PG8_LDB(B0, 0, 0); PG8_SCHED; PG8_LDA(At, 0, 0); PG8_STAGE(PG8_SA(1, 1), a1 + hstep, voffA);
            PG8_WAIT_L(8); PG8_BAR; PG8_WAIT_L(0); PG8_MMA(0, 0, At, B0); PG8_BAR; PG8_SCHED;
            PG8_LDB(B1, 0, 1); PG8_STAGE(PG8_SB(0, 0), b2, voffB);
            PG8_BAR; PG8_WAIT_L(0); PG8_MMA(0, 1, At, B1); PG8_BAR;
            PG8_LDA(At, 0, 1); PG8_STAGE(PG8_SA(0, 0), a2, voffA);
            PG8_BAR; PG8_WAIT_L(0); PG8_MMA(1, 0, At, B0); PG8_BAR; PG8_SCHED;
            PG8_STAGE(PG8_SB(0, 1), b2 + hstep, voffB);
            PG8_WAIT_V(6); PG8_BAR; PG8_MMA(1, 1, At, B1); PG8_BAR;
            PG8_LDB(B0, 1, 0); PG8_SCHED; PG8_LDA(At, 1, 0); PG8_STAGE(PG8_SA(0, 1), a2 + hstep, voffA);
            PG8_WAIT_L(8); PG8_BAR; PG8_WAIT_L(0); PG8_MMA(0, 0, At, B0); PG8_BAR; PG8_SCHED;
            PG8_LDB(B1, 1, 1); PG8_STAGE(PG8_SB(1, 0), b3, voffB);
            PG8_BAR; PG8_WAIT_L(0); PG8_MMA(0, 1, At, B1); PG8_BAR;
            PG8_LDA(At, 1, 1); PG8_STAGE(PG8_SA(1, 0), a3, voffA);
            PG8_BAR; PG8_WAIT_L(0); PG8_MMA(1, 0, At, B0); PG8_BAR; PG8_SCHED;
            PG8_STAGE(PG8_SB(1, 1), b3 + hstep, voffB);
            PG8_WAIT_V(6); PG8_BAR; PG8_MMA(1, 1, At, B1); PG8_BAR;
            }
        }
        if constexpr (ALIGN_EPI) { if (wr == 0) PG8_BAR; }
        E(acc, cur, wr, wc, fr, fq);
        if (!has_next) break;
#pragma unroll
        for (int a = 0; a < 2; ++a)
#pragma unroll
            for (int b = 0; b < 2; ++b)
#pragma unroll
                for (int m = 0; m < 4; ++m)
#pragma unroll
                    for (int n = 0; n < 2; ++n) acc[a][b][m][n] = (f32x4){0.f, 0.f, 0.f, 0.f};
        cur = nxt; cA = nA; cB = nB; ++ui;
        if constexpr (ALIGN_EPI) { if (wr == 1) PG8_BAR; }
    }
    PG8_WAIT_V(0);
    if constexpr (!ALIGN_EPI) { if (wr == 0) PG8_BAR; }
    PG8_BAR;
#undef PG8_SA
#undef PG8_SB
#undef PG8_STAGE
#undef PG8_LDA
#undef PG8_LDB
#undef PG8_MMA
#undef PG8_WAIT_V
#undef PG8_WAIT_L
#undef PG8_BAR
#undef PG8_SCHED
}
}
using pg8::Unit;

struct SchedStd : pg8::TileOrder {
    const char* A; const char* B; size_t tstep;
    __device__ __forceinline__ const char* a_base(const Unit& u) const { return A + (size_t)u.pm * tstep; }
    __device__ __forceinline__ const char* b_base(const Unit& u) const { return B + (size_t)u.pn * tstep; }
};
struct SchedWin : pg8::TileOrder {
    const char* XN; const char* W; size_t tstep;
    __device__ __forceinline__ const char* a_base(const Unit& u) const { return u.pn < 4 ? XN + (size_t)u.pm * tstep : W + (size_t)u.pn * tstep; }
    __device__ __forceinline__ const char* b_base(const Unit& u) const { return u.pn < 4 ? W + (size_t)u.pn * tstep : XN + (size_t)u.pm * tstep; }
};

struct EpiWin {
    static constexpr bool PERM = true;
    bf16_t* prg; bf16_t* phy;
    __device__ __forceinline__ void operator()(const f32x4 (&acc)[2][2][4][2], const Unit& u, int wr, int wc, int fr, int fq) const {
        bf16_t* base; size_t ldc; int r0, c0;
        if (u.pn < 4) { base = prg; ldc = 1024; r0 = u.pm * 256; c0 = u.pn * 256; }
        else {
            r0 = (u.pn - 4) * 256; c0 = 0;
            if (u.pm < 32) { base = phy + (size_t)u.pm * 1536 * 256; ldc = 256; }
            else { const int b = (u.pm - 32) >> 4, t0 = ((u.pm - 32) & 15) * 256; base = phy + PHY_LAT_OFF + (size_t)b * 1536 * 4096 + t0; ldc = 4096; }
        }
        const int row0 = r0 + wr * 64 + fr, col0 = c0 + wc * 32 + 8 * fq;
#pragma unroll
        for (int ai = 0; ai < 2; ++ai)
#pragma unroll
            for (int m = 0; m < 4; ++m) { bf16_t* rowp = base + (size_t)(row0 + ai * 128 + m * 16) * ldc + col0;
#pragma unroll
                for (int bj = 0; bj < 2; ++bj) { const f32x4 v0 = acc[ai][bj][m][0], v1 = acc[ai][bj][m][1];
                    u32x4 w; w.x = pg8::cvt_pk_bf16(v0[0], v0[1]); w.y = pg8::cvt_pk_bf16(v0[2], v0[3]); w.z = pg8::cvt_pk_bf16(v1[0], v1[1]); w.w = pg8::cvt_pk_bf16(v1[2], v1[3]);
                    *(u32x4*)(rowp + bj * 128) = w; } }
    }
};
struct EpiUp {
    static constexpr bool PERM = true;
    bf16_t* A; bf16_t* Gb; int nt; int ldc;
    __device__ __forceinline__ void operator()(const f32x4 (&acc)[2][2][4][2], const Unit& u, int wr, int wc, int fr, int fq) const {
        bf16_t* base = u.pn < nt ? A : Gb; const int ct = u.pn < nt ? u.pn : u.pn - nt;
        const int row0 = u.pm * 256 + wr * 64 + fr, col0 = ct * 256 + wc * 32 + 8 * fq;
#pragma unroll
        for (int ai = 0; ai < 2; ++ai)
#pragma unroll
            for (int m = 0; m < 4; ++m) { bf16_t* rowp = base + (size_t)(row0 + ai * 128 + m * 16) * ldc + col0;
#pragma unroll
                for (int bj = 0; bj < 2; ++bj) { const f32x4 v0 = acc[ai][bj][m][0], v1 = acc[ai][bj][m][1];
                    u32x4 w; w.x = pg8::cvt_pk_bf16(v0[0], v0[1]); w.y = pg8::cvt_pk_bf16(v0[2], v0[3]); w.z = pg8::cvt_pk_bf16(v1[0], v1[1]); w.w = pg8::cvt_pk_bf16(v1[2], v1[3]);
                    *(u32x4*)(rowp + bj * 128) = w; } }
    }
};
template <bool F32SRC> struct EpiResT {
    static constexpr bool PERM = true;
    const float* xin_ctx; const float* xin_lat;
    const bf16_t* xin_b; bf16_t* out_b;
    const float* gate;
    bool dry;
    __device__ __forceinline__ void operator()(const f32x4 (&acc)[2][2][4][2], const Unit& u, int wr, int wc, int fr, int fq) const {
        if (dry) return;
        const int row0 = u.pm * 256 + wr * 64 + fr, col0 = u.pn * 256 + wc * 32 + 8 * fq;
        const float* gp = gate + (size_t)((u.pm < 32) ? 0 : 1 + ((u.pm - 32) >> 4)) * 6144 + col0;
        f32x4 gv[2][2];
#pragma unroll
        for (int bj = 0; bj < 2; ++bj)
#pragma unroll
            for (int n = 0; n < 2; ++n) gv[bj][n] = *(const f32x4*)(gp + bj * 128 + n * 4);
        if constexpr (F32SRC) {
            const float* xin = (u.pm < 32) ? xin_ctx : xin_lat;
#pragma unroll
            for (int ai = 0; ai < 2; ++ai)
#pragma unroll
                for (int mh = 0; mh < 2; ++mh) {
                    f32x4 xo[2][2][2];
#pragma unroll
                    for (int mm = 0; mm < 2; ++mm) { const size_t off = (size_t)(row0 + ai * 128 + (mh * 2 + mm) * 16) * 1024 + col0;
#pragma unroll
                        for (int bj = 0; bj < 2; ++bj)
#pragma unroll
                            for (int n = 0; n < 2; ++n) xo[mm][bj][n] = __builtin_nontemporal_load((const f32x4*)(xin + off + bj * 128 + n * 4)); }
#pragma unroll
                    for (int mm = 0; mm < 2; ++mm) { const size_t off = (size_t)(row0 + ai * 128 + (mh * 2 + mm) * 16) * 1024 + col0;
#pragma unroll
                        for (int bj = 0; bj < 2; ++bj) { const f32x4 v0 = xo[mm][bj][0] + gv[bj][0] * acc[ai][bj][mh * 2 + mm][0], v1 = xo[mm][bj][1] + gv[bj][1] * acc[ai][bj][mh * 2 + mm][1];
                            u32x4 w; w.x = pk2(v0[0], v0[1]); w.y = pk2(v0[2], v0[3]); w.z = pk2(v1[0], v1[1]); w.w = pk2(v1[2], v1[3]);
                            *(u32x4*)(out_b + off + bj * 128) = w; } }
                }
        } else {
#pragma unroll
            for (int ai = 0; ai < 2; ++ai) {
                u32x4 xo[4][2];
#pragma unroll
                for (int m = 0; m < 4; ++m) { const size_t off = (size_t)(row0 + ai * 128 + m * 16) * 1024 + col0;
#pragma unroll
                    for (int bj = 0; bj < 2; ++bj) xo[m][bj] = *(const u32x4*)(xin_b + off + bj * 128); }
#pragma unroll
                for (int m = 0; m < 4; ++m) { const size_t off = (size_t)(row0 + ai * 128 + m * 16) * 1024 + col0;
#pragma unroll
                    for (int bj = 0; bj < 2; ++bj) { const u32x4 x = xo[m][bj];
                        const f32x4 a0 = acc[ai][bj][m][0], a1 = acc[ai][bj][m][1], g0 = gv[bj][0], g1 = gv[bj][1];
                        u32x4 w;
                        w.x = pk2(bf2f(x.x & 0xffffu) + g0[0] * a0[0], bf2f(x.x >> 16) + g0[1] * a0[1]);
                        w.y = pk2(bf2f(x.y & 0xffffu) + g0[2] * a0[2], bf2f(x.y >> 16) + g0[3] * a0[3]);
                        w.z = pk2(bf2f(x.z & 0xffffu) + g1[0] * a1[0], bf2f(x.z >> 16) + g1[1] * a1[1]);
                        w.w = pk2(bf2f(x.w & 0xffffu) + g1[2] * a1[2], bf2f(x.w >> 16) + g1[3] * a1[3]);
                        *(u32x4*)(out_b + off + bj * 128) = w; } }
            }
        }
    }
};

__device__ __forceinline__ void phase_mod(CP& p, unsigned char* smem) {
    float* S = (float*)smem;
    float* red = (float*)(smem + 5 * 1024 * 4);
    const int tid = opaque_tid();
    if ((int)blockIdx.x >= 384) return;
    for (int i = tid; i < 5 * 1024; i += NTHR) { const int r = i >> 10, k = i & 1023; const float v = r == 0 ? p.in[I_CCTX][k] : p.in[I_C][(r - 1) * 1024 + k]; S[i] = v / (1.0f + __expf(-v)); }
    __syncthreads();
    float* MOD = (float*)(p.ws + WS_MOD);
    for (int it = blockIdx.x; it < 384; it += gridDim.x) {
        const int l = it / 192, cg_ = it % 192, q = tid & 7, rg = tid >> 3;
        const float* W = p.in[I_WADA] + (size_t)l * 1024 * 6144 + cg_ * 32 + q * 4;
        float acc[5][4];
#pragma unroll
        for (int r = 0; r < 5; ++r)
#pragma unroll
            for (int j = 0; j < 4; ++j) acc[r][j] = 0.f;
#pragma unroll 4
        for (int kk = 0; kk < 16; ++kk) { const int k = rg * 16 + kk; const f32x4 w = __builtin_nontemporal_load((const f32x4*)(W + (size_t)k * 6144));
#pragma unroll
            for (int r = 0; r < 5; ++r) { const float s = S[r * 1024 + k];
#pragma unroll
                for (int j = 0; j < 4; ++j) acc[r][j] += s * w[j]; } }
#pragma unroll
        for (int r = 0; r < 5; ++r)
#pragma unroll
            for (int j = 0; j < 4; ++j) red[(rg * 5 + r) * 32 + q * 4 + j] = acc[r][j];
        __syncthreads();
        if (tid < 160) { const int r = tid >> 5, cc = tid & 31; float s = 0.f;
            for (int g = 0; g < 64; ++g) s += red[(g * 5 + r) * 32 + cc];
            const int col = cg_ * 32 + cc;
            MOD[((size_t)l * 5 + r) * 6144 + col] = s + p.in[I_BADA][l * 6144 + col]; }
        __syncthreads();
    }
}

__device__ __forceinline__ void phase_h2(CP& p, unsigned char* smem) {
    { float* SP = (float*)(p.ws + WS_SP);
      for (int i = blockIdx.x * NTHR + threadIdx.x; i < 2 * 2 * 512; i += gridDim.x * NTHR) SP[i] = 8.0f * log1pf(expf(-p.in[I_RGA][i])); }
    { bf16_t* W3T = (bf16_t*)(p.ws + WS_W3T);
      for (int i = blockIdx.x * NTHR + threadIdx.x; i < 2 * 2048 * 64; i += gridDim.x * NTHR) { const int k = i & 63, col = (i >> 6) & 2047, ll = i >> 17;
          W3T[i] = (bf16_t)f2bf(p.in[I_HFW3][((size_t)ll * 64 + k) * 2048 + col]); } }
    float* F = (float*)smem;
    float* H1 = (float*)(smem + 8 * 33 * 4 + 32);
    const int tid = opaque_tid(), pi = tid >> 6, j = tid & 63;
    float* H2 = (float*)(p.ws + WS_H2);
    for (int it = blockIdx.x; it < 1088; it += gridDim.x) {
        const int Pg = it * 8 + pi, l = Pg / 4352, pp = Pg % 4352;
        const int path = pp < 256 ? 0 : 1, pos = path ? pp - 256 : pp, L = path ? 4096 : 256;
        if (j < 33) {
            const float t = (float)pos / (float)(L - 1);
            const float omega = 6.283185307179586f * (float)pos / (float)L;
            float f;
            if (j == 0) f = t;
            else { const int bi = (j - 1) & 15; const float band = 1e-4f + (float)bi * ((15.0f - 1e-4f) / 15.0f); const float ang = omega * band; f = j <= 16 ? cosf(ang) : sinf(ang); }
            F[pi * 33 + j] = f;
        }
        __syncthreads();
        {
            const float* w1 = p.in[I_HFW1] + (size_t)l * 33 * 64; float s = p.in[I_HFB1][l * 64 + j];
            for (int k = 0; k < 33; ++k) s += F[pi * 33 + k] * w1[k * 64 + j];
            H1[pi * 64 + j] = sinf(p.in[I_HFFR][l * 128 + j] * s);
        }
        __syncthreads();
        {
            const float* w2 = p.in[I_HFW2] + (size_t)l * 64 * 64; float s = p.in[I_HFB2][l * 64 + j];
            for (int k = 0; k < 64; ++k) s += H1[pi * 64 + k] * w2[k * 64 + j];
            const float hv = sinf(p.in[I_HFFR][l * 128 + 64 + j] * s);
            H2[((size_t)l * 4352 + pp) * 64 + j] = hv;
            ((bf16_t*)(p.ws + WS_H2B))[((size_t)l * 4352 + pp) * 64 + j] = (bf16_t)f2bf(hv);
        }
        __syncthreads();
    }
}

struct WTile { const float* src; bf16_t* dst; int N, k0s, n0s, ldk, kcol0; };
__device__ __forceinline__ WTile wtile_decode(CP& p, int l, int id) {
    WTile t; int kt, ntile;
    if (id < 640) { t.src = p.in[I_WIN] + (size_t)l * 1024 * 2560; t.N = 2560; kt = id / 40; ntile = id % 40; t.dst = (bf16_t*)(p.ws + WS_WIN) + (size_t)ntile * 64 * 1024; t.ldk = 1024; t.kcol0 = kt * 64; }
    else if (id < 896) { id -= 640; t.src = p.in[I_WOUT] + (size_t)l * 1024 * 1024; t.N = 1024; kt = id / 16; ntile = id % 16; t.dst = (bf16_t*)(p.ws + WS_WOUT) + (size_t)ntile * 64 * 1024; t.ldk = 1024; t.kcol0 = kt * 64; }
    else if (id < 2304) { t.src = p.in[I_WUP] + (size_t)l * 1024 * 5632; t.N = 5632;
        if (id < 1664) { id -= 896; const int nti = id >> 4; kt = id & 15; ntile = nti < 24 ? nti : 44 + (nti - 24); }
        else { id -= 1664; const int nti = id >> 4; kt = id & 15; ntile = nti < 20 ? 24 + nti : 68 + (nti - 20); }
        const int n0 = ntile * 64; int dr;
        if (n0 < 2816) dr = n0 < 1536 ? n0 : 3072 + (n0 - 1536); else { const int jn = n0 - 2816; dr = jn < 1536 ? 1536 + jn : 4352 + (jn - 1536); }
        t.dst = (bf16_t*)(p.ws + WS_WUP) + (size_t)dr * 1024; t.ldk = 1024; t.kcol0 = kt * 64; }
    else { id -= 2304; t.src = p.in[I_WDN] + (size_t)l * 2816 * 1024; t.N = 1024; kt = id >> 4; ntile = id & 15;
        const int k0 = kt * 64;
        if (k0 < 1536) { t.dst = (bf16_t*)(p.ws + WS_WDN0) + (size_t)ntile * 64 * 1536; t.ldk = 1536; t.kcol0 = k0; }
        else { t.dst = (bf16_t*)(p.ws + WS_WDN1) + (size_t)ntile * 64 * 1280; t.ldk = 1280; t.kcol0 = k0 - 1536; } }
    t.k0s = kt * 64; t.n0s = ntile * 64;
    return t;
}
__device__ __forceinline__ void phase_wconv(CP& p, int l, int lo, int hi, int first, int stride, bool do_gw, unsigned char* smem) {
    float* T = (float*)smem;
    const int tid = opaque_tid();
    for (int it = lo + first; it < hi; it += 2 * stride) {
        const bool two = it + stride < hi;
        const WTile ta = wtile_decode(p, l, it), tb = wtile_decode(p, l, two ? it + stride : it);
        const int kk = tid >> 4, n4 = (tid & 15) * 4;
        f32x4 va[2], vb[2];
#pragma unroll
        for (int h = 0; h < 2; ++h) { va[h] = __builtin_nontemporal_load((const f32x4*)(ta.src + (size_t)(ta.k0s + kk + h * 32) * ta.N + ta.n0s + n4));
            vb[h] = __builtin_nontemporal_load((const f32x4*)(tb.src + (size_t)(tb.k0s + kk + h * 32) * tb.N + tb.n0s + n4)); }
#pragma unroll
        for (int h = 0; h < 2; ++h) { float* tp = T + (kk + h * 32) * 65 + n4; tp[0] = va[h][0]; tp[1] = va[h][1]; tp[2] = va[h][2]; tp[3] = va[h][3];
            float* tq = T + 64 * 65 + (kk + h * 32) * 65 + n4; tq[0] = vb[h][0]; tq[1] = vb[h][1]; tq[2] = vb[h][2]; tq[3] = vb[h][3]; }
        __syncthreads();
        {
            const int nn = tid >> 3, k8 = (tid & 7) * 8; float v[8];
#pragma unroll
            for (int e = 0; e < 8; ++e) v[e] = T[(k8 + e) * 65 + nn];
            u32x4 w; w.x = pk2(v[0], v[1]); w.y = pk2(v[2], v[3]); w.z = pk2(v[4], v[5]); w.w = pk2(v[6], v[7]);
            *(u32x4*)(ta.dst + (size_t)nn * ta.ldk + ta.kcol0 + k8) = w;
            if (two) {
#pragma unroll
                for (int e = 0; e < 8; ++e) v[e] = T[64 * 65 + (k8 + e) * 65 + nn];
                w.x = pk2(v[0], v[1]); w.y = pk2(v[2], v[3]); w.z = pk2(v[4], v[5]); w.w = pk2(v[6], v[7]);
                *(u32x4*)(tb.dst + (size_t)nn * tb.ldk + tb.kcol0 + k8) = w;
            }
        }
        __syncthreads();
    }
    if (!do_gw) return;
    bf16_t* GW = (bf16_t*)(p.ws + WS_GW);
    const float* gsrc = p.in[I_RGGW] + (size_t)l * 65536 * 2;
    for (int i = blockIdx.x * NTHR + tid; i < 131072; i += gridDim.x * NTHR) {
        const int ii = i & 63, j = (i >> 6) & 63, dgh = i >> 12;
        GW[i] = (bf16_t)f2bf(gsrc[((size_t)dgh * 64 + ii) * 64 + j]);
    }
}

__device__ __forceinline__ void unpack8(const u32x4 r, float (&f)[8]) {
    f[0] = __uint_as_float(r.x << 16); f[1] = __uint_as_float(r.x & 0xffff0000u); f[2] = __uint_as_float(r.y << 16); f[3] = __uint_as_float(r.y & 0xffff0000u);
    f[4] = __uint_as_float(r.z << 16); f[5] = __uint_as_float(r.z & 0xffff0000u); f[6] = __uint_as_float(r.w << 16); f[7] = __uint_as_float(r.w & 0xffff0000u);
}
__device__ __forceinline__ void norm_emit(const float (&v)[4][2][8], int row, const float* mr, const float (&gg)[2][8], bf16_t* XN, int lane) {
    float sh[2][8], sc[2][8];
#pragma unroll
    for (int hh = 0; hh < 2; ++hh) { const f32x4 a = *(const f32x4*)(mr + hh * 512 + lane * 8), b = *(const f32x4*)(mr + hh * 512 + lane * 8 + 4);
        const f32x4 c = *(const f32x4*)(mr + 1024 + hh * 512 + lane * 8), d = *(const f32x4*)(mr + 1024 + hh * 512 + lane * 8 + 4);
#pragma unroll
        for (int e = 0; e < 4; ++e) { sh[hh][e] = a[e]; sh[hh][4 + e] = b[e]; sc[hh][e] = gg[hh][e] * (1.0f + c[e]); sc[hh][4 + e] = gg[hh][4 + e] * (1.0f + d[e]); } }
#pragma unroll
    for (int r = 0; r < 4; ++r) {
        float ss = 0.f;
#pragma unroll
        for (int hh = 0; hh < 2; ++hh)
#pragma unroll
            for (int e = 0; e < 8; ++e) ss += v[r][hh][e] * v[r][hh][e];
        ss = wave_sum(ss);
        const float rstd = rsqrtf(ss * (1.0f / 1024.0f) + EPS);
#pragma unroll
        for (int hh = 0; hh < 2; ++hh) { float o[8];
#pragma unroll
            for (int e = 0; e < 8; ++e) o[e] = (v[r][hh][e] * rstd) * sc[hh][e] + sh[hh][e];
            u32x4 w; w.x = pk2(o[0], o[1]); w.y = pk2(o[2], o[3]); w.z = pk2(o[4], o[5]); w.w = pk2(o[6], o[7]);
            *(u32x4*)(XN + (size_t)(row + r) * 1024 + hh * 512 + lane * 8) = w; }
    }
}
__device__ __forceinline__ void phase_norm(CP& p, int l, int which) {
    const int tid = opaque_tid(), wave = tid >> 6, lane = tid & 63;
    const float* g = p.in[which ? I_GN2 : I_GN1] + l * 1024;
    const float* MOD = (const float*)(p.ws + WS_MOD) + (size_t)l * 5 * 6144;
    bf16_t* XN = (bf16_t*)(p.ws + WS_XN);
    const bf16_t* XB = (const bf16_t*)p.out;
    const bool f32src = (l == 0 && which == 0);
    const int G = gridDim.x;
    float gg[2][8];
#pragma unroll
    for (int hh = 0; hh < 2; ++hh) { const f32x4 a = *(const f32x4*)(g + hh * 512 + lane * 8), b = *(const f32x4*)(g + hh * 512 + lane * 8 + 4);
        gg[hh][0] = a[0]; gg[hh][1] = a[1]; gg[hh][2] = a[2]; gg[hh][3] = a[3]; gg[hh][4] = b[0]; gg[hh][5] = b[1]; gg[hh][6] = b[2]; gg[hh][7] = b[3]; }
    if (f32src) {
        for (int rb = blockIdx.x; rb < MTOK / 32; rb += G) {
            const int row = rb * 32 + wave * 4;
            const float* mr = MOD + (size_t)mod_row(row) * 6144 + (which ? 3072 : 0);
            const float* x = row < NCTX ? p.in[I_XP] + (size_t)row * 1024 : p.in[I_XS] + (size_t)(row - NCTX) * 1024;
            f32x4 raw[4][2][2];
#pragma unroll
            for (int r = 0; r < 4; ++r)
#pragma unroll
                for (int hh = 0; hh < 2; ++hh) { raw[r][hh][0] = __builtin_nontemporal_load((const f32x4*)(x + r * 1024 + hh * 512 + lane * 8)); raw[r][hh][1] = __builtin_nontemporal_load((const f32x4*)(x + r * 1024 + hh * 512 + lane * 8 + 4)); }
            float v[4][2][8];
#pragma unroll
            for (int r = 0; r < 4; ++r)
#pragma unroll
                for (int hh = 0; hh < 2; ++hh)
#pragma unroll
                    for (int e = 0; e < 4; ++e) { v[r][hh][e] = raw[r][hh][0][e]; v[r][hh][4 + e] = raw[r][hh][1][e]; }
            norm_emit(v, row, mr, gg, XN, lane);
        }
    } else {
        int rb = blockIdx.x;
        u32x4 cur[4][2];
        if (rb < MTOK / 32) {
#pragma unroll
            for (int r = 0; r < 4; ++r)
#pragma unroll
                for (int hh = 0; hh < 2; ++hh) cur[r][hh] = __builtin_nontemporal_load((const u32x4*)(XB + (size_t)(rb * 32 + wave * 4 + r) * 1024 + hh * 512 + lane * 8));
        }
        for (; rb < MTOK / 32; rb += G) {
            const int row = rb * 32 + wave * 4, rbn = rb + G;
            const float* mr = MOD + (size_t)mod_row(row) * 6144 + (which ? 3072 : 0);
            u32x4 nxt[4][2];
            if (rbn < MTOK / 32) {
#pragma unroll
                for (int r = 0; r < 4; ++r)
#pragma unroll
                    for (int hh = 0; hh < 2; ++hh) nxt[r][hh] = __builtin_nontemporal_load((const u32x4*)(XB + (size_t)(rbn * 32 + wave * 4 + r) * 1024 + hh * 512 + lane * 8));
            }
            float v[4][2][8];
#pragma unroll
            for (int r = 0; r < 4; ++r)
#pragma unroll
                for (int hh = 0; hh < 2; ++hh) unpack8(cur[r][hh], v[r][hh]);
            norm_emit(v, row, mr, gg, XN, lane);
            if (rbn < MTOK / 32) {
#pragma unroll
                for (int r = 0; r < 4; ++r)
#pragma unroll
                    for (int hh = 0; hh < 2; ++hh) cur[r][hh] = nxt[r][hh];
            }
        }
    }
}
__device__ __forceinline__ void phase_final_norm(CP& p) {
    const int tid = opaque_tid(), wave = tid >> 6, lane = tid & 63;
    const float* g = p.in[I_GFIN];
    const bf16_t* XF = (const bf16_t*)(p.ws + WS_XN);
    float gg[2][8];
#pragma unroll
    for (int hh = 0; hh < 2; ++hh) { const f32x4 a = *(const f32x4*)(g + hh * 512 + lane * 8), b = *(const f32x4*)(g + hh * 512 + lane * 8 + 4);
        gg[hh][0] = a[0]; gg[hh][1] = a[1]; gg[hh][2] = a[2]; gg[hh][3] = a[3]; gg[hh][4] = b[0]; gg[hh][5] = b[1]; gg[hh][6] = b[2]; gg[hh][7] = b[3]; }
    for (int rb = blockIdx.x; rb < MTOK / 32; rb += gridDim.x) {
        const int row = rb * 32 + wave * 4;
        u32x4 raw[4][2];
#pragma unroll
        for (int r = 0; r < 4; ++r)
#pragma unroll
            for (int hh = 0; hh < 2; ++hh) raw[r][hh] = __builtin_nontemporal_load((const u32x4*)(XF + (size_t)(row + r) * 1024 + hh * 512 + lane * 8));
#pragma unroll
        for (int r = 0; r < 4; ++r) {
            float v[2][8]; float ss = 0.f;
#pragma unroll
            for (int hh = 0; hh < 2; ++hh) { unpack8(raw[r][hh], v[hh]);
#pragma unroll
                for (int e = 0; e < 8; ++e) ss += v[hh][e] * v[hh][e]; }
            ss = wave_sum(ss);
            const float rstd = rsqrtf(ss * (1.0f / 1024.0f) + EPS);
#pragma unroll
            for (int hh = 0; hh < 2; ++hh) { f32x4 o0, o1;
#pragma unroll
                for (int e = 0; e < 4; ++e) { o0[e] = (v[hh][e] * rstd) * gg[hh][e]; o1[e] = (v[hh][4 + e] * rstd) * gg[hh][4 + e]; }
                float* dst = p.out + (size_t)(row + r) * 1024 + hh * 512 + lane * 8;
                *(f32x4*)dst = o0; *(f32x4*)(dst + 4) = o1; }
        }
    }
}

__device__ __forceinline__ void phase_taps(CP& p, int l, unsigned char* smem) {
    const int tid = opaque_tid(), lane = tid & 63, wv = __builtin_amdgcn_readfirstlane(tid >> 6), fr = lane & 15, fq = lane >> 4;
    const bf16_t* H2b = (const bf16_t*)(p.ws + WS_H2B) + (size_t)l * 4352 * 64;
    const bf16_t* W3T = (const bf16_t*)(p.ws + WS_W3T) + (size_t)l * 2048 * 64;
    float* TAPS = (float*)(p.ws + WS_TAPS);
    for (int it = blockIdx.x; it < 544; it += gridDim.x) {
        const int ptile = it >> 3, cb = it & 7;
        const int path = ptile < 4 ? 0 : 1, pos0 = (path ? ptile - 4 : ptile) * 64, L = path ? 4096 : 256;
        const int pp0 = path ? 256 + pos0 : pos0, col0 = cb * 256 + wv * 32;
        bf16x8 a[4][2], b[2][2];
#pragma unroll
        for (int pt = 0; pt < 4; ++pt)
#pragma unroll
            for (int kk = 0; kk < 2; ++kk) a[pt][kk] = *(const bf16x8*)(H2b + (size_t)(pp0 + pt * 16 + fr) * 64 + kk * 32 + fq * 8);
#pragma unroll
        for (int ct = 0; ct < 2; ++ct)
#pragma unroll
            for (int kk = 0; kk < 2; ++kk) b[ct][kk] = *(const bf16x8*)(W3T + (size_t)(col0 + ct * 16 + fr) * 64 + kk * 32 + fq * 8);
        float* outb = TAPS + (path ? TAPS_LAT_OFF : 0);
        const float invL = 1.0f / (float)(L - 1);
#pragma unroll
        for (int ct = 0; ct < 2; ++ct) {
            const int col = col0 + ct * 16 + fr, c = col & 511;
            const float delta = fabsf(-3.0701134573253945f + (float)c * ((-15.350567286626972f + 3.0701134573253945f) / 511.0f));
#pragma unroll
            for (int pt = 0; pt < 4; ++pt) {
                f32x4 acc = (f32x4){0.f, 0.f, 0.f, 0.f};
#pragma unroll
                for (int kk = 0; kk < 2; ++kk) acc = __builtin_amdgcn_mfma_f32_16x16x32_bf16(a[pt][kk], b[ct][kk], acc, 0, 0, 0);
                const int pos = pos0 + pt * 16 + fq * 4;
                f32x4 o;
#pragma unroll
                for (int jj = 0; jj < 4; ++jj) o[jj] = acc[jj] * __expf(-((float)(pos + jj) * invL) * delta);
                *(f32x4*)(outb + (size_t)col * L + pos) = o;
            }
        }
    }
}

constexpr int RG_XR = 0, RG_YR = 35840, RG_OR = 68608, RG_XCB = 101376;
template <bool REV, bool WANT_H>
__device__ __forceinline__ void rg_scan_tile(const float (&a)[4], float (&b)[4], float hc, int lane, float& AT, float& BT) {
    const int q = lane >> 4, pos = REV ? 3 - q : q;
    float IA = 1.f, IB = 0.f;
#pragma unroll
    for (int jj = 0; jj < 4; ++jj) { const int j = REV ? 3 - jj : jj; IB = a[j] * IB + b[j]; IA *= a[j]; }
    {
        const int src = (REV ? lane + 16 : lane - 16) & 63;
        const float pA = __shfl(IA, src), pB = __shfl(IB, src);
        if (pos >= 1) { IB = IA * pB + IB; IA = pA * IA; }
    }
    {
        const int src = (REV ? lane + 32 : lane - 32) & 63;
        const float pA = __shfl(IA, src), pB = __shfl(IB, src);
        if (pos >= 2) { IB = IA * pB + IB; IA = pA * IA; }
    }
    const int last = (REV ? 0 : 48) + (lane & 15);
    AT = __shfl(IA, last); BT = __shfl(IB, last);
    if (WANT_H) {
        const int src = (REV ? lane + 16 : lane - 16) & 63;
        float EA = __shfl(IA, src), EB = __shfl(IB, src);
        if (pos == 0) { EA = 1.f; EB = 0.f; }
        float h = EA * hc + EB;
#pragma unroll
        for (int jj = 0; jj < 4; ++jj) { const int j = REV ? 3 - jj : jj; h = a[j] * h + b[j]; b[j] = h; }
    }
}
template <int PASS>
__device__ __forceinline__ void rg_item(CP& p, int l, int ci, unsigned char* smem) {
    const int tid = opaque_tid(), lane = tid & 63, wave = __builtin_amdgcn_readfirstlane(tid >> 6), fr = lane & 15, fq = lane >> 4;
    bf16_t* XR = (bf16_t*)(smem + RG_XR);
    bf16_t* YR = (bf16_t*)(smem + RG_YR);
    bf16_t* OR = (bf16_t*)(smem + RG_OR);
    bf16_t* XCb = (bf16_t*)(smem + RG_XCB) + wave * (32 * 72);
    const bf16_t* PRG = (const bf16_t*)(p.ws + WS_PRG);
    float2* AGG = (float2*)(p.ws + WS_AGG);
    const bf16_t* GW = (const bf16_t*)(p.ws + WS_GW);
    const float* SPt = (const float*)(p.ws + WS_SP) + l * 1024;
    const float* GBt = p.in[I_RGGB] + l * 2048;
    int s, k, nch, L, cibase;
    if (ci < 256) { s = ci >> 3; k = ci & 7; nch = 8; L = 256; cibase = ci - k; }
    else { const int cl = ci - 256; s = 32 + (cl >> 7); k = cl & 127; nch = 128; L = 4096; cibase = ci - k; }
    const int r0 = ci * 32, t0 = k * 32;
    const int h = wave, chl = h * 64 + lane;
    {
        u32x4 vals[5], yv[4];
#pragma unroll
        for (int i = 0; i < 5; ++i) { const int v = tid + i * NTHR, rr = v >> 6, cv = v & 63; const int t = t0 - 2 + rr;
            vals[i] = (u32x4){0u, 0u, 0u, 0u};
            if (rr < 35 && t >= 0 && t < L) vals[i] = *(const u32x4*)(PRG + (size_t)(r0 - 2 + rr) * 1024 + cv * 8); }
        if (PASS == 3) {
#pragma unroll
            for (int i = 0; i < 4; ++i) { const int v = tid + i * NTHR, rr = v >> 6, cv = v & 63; yv[i] = *(const u32x4*)(PRG + (size_t)(r0 + rr) * 1024 + 512 + cv * 8); }
        }
#pragma unroll
        for (int i = 0; i < 5; ++i) { const int v = tid + i * NTHR, rr = v >> 6, cv = v & 63;
            if (rr < 35) *(u32x4*)(XR + rr * 512 + cv * 8) = vals[i]; }
        if (PASS == 3) {
#pragma unroll
            for (int i = 0; i < 4; ++i) { const int v = tid + i * NTHR, rr = v >> 6, cv = v & 63; *(u32x4*)(YR + rr * 512 + cv * 8) = yv[i]; }
        }
    }
    float cf = 0.f, cbk = 0.f;
    if (PASS == 3) {
        if (s >= 32) { const float* st = p.in[I_ST] + ((size_t)((s - 32) * 2 + l) * 2) * 512; cf = st[chl]; cbk = st[512 + chl]; }
#pragma unroll 32
        for (int j = 0; j < k; ++j) { const float2 ab = AGG[((size_t)(cibase + j) * 2 + 0) * 512 + chl]; cf = ab.x * cf + ab.y; }
#pragma unroll 32
        for (int j = nch - 1; j > k; --j) { const float2 ab = AGG[((size_t)(cibase + j) * 2 + 1) * 512 + chl]; cbk = ab.x * cbk + ab.y; }
    }
    const float* cwp = p.in[I_RGCW] + (size_t)l * 4 * 512;
    const float w0 = cwp[chl], w1 = cwp[512 + chl], w2 = cwp[1024 + chl], w3 = cwp[1536 + chl], wb = p.in[I_RGCB][l * 512 + chl];
    __syncthreads();
    {
        float x0 = bf2f(XR[0 * 512 + chl]), x1 = bf2f(XR[1 * 512 + chl]), x2 = bf2f(XR[2 * 512 + chl]);
#pragma unroll
        for (int t = 0; t < 32; ++t) { const float x3 = bf2f(XR[(t + 3) * 512 + chl]);
            XCb[t * 72 + lane] = (bf16_t)f2bf(wb + w0 * x0 + w1 * x1 + w2 * x2 + w3 * x3); x0 = x1; x1 = x2; x2 = x3; }
    }
    asm volatile("s_waitcnt lgkmcnt(0)" ::: "memory");
    bf16x8 afr[2][2];
#pragma unroll
    for (int tb = 0; tb < 2; ++tb)
#pragma unroll
        for (int kk = 0; kk < 2; ++kk) afr[tb][kk] = *(const bf16x8*)(XCb + (tb * 16 + fr) * 72 + kk * 32 + fq * 8);
    float* ns = p.out + (size_t)MTOK * 1024 + ((size_t)((s & 31) * 2 + l) * 2) * 512;
    bf16x8 bcur[2][2][2]; float ccur[2][3];
#pragma unroll
    for (int d = 0; d < 2; ++d) {
#pragma unroll
        for (int g = 0; g < 2; ++g)
#pragma unroll
            for (int kk = 0; kk < 2; ++kk) bcur[d][g][kk] = *(const bf16x8*)(GW + ((size_t)(((d * 2 + g) * 8 + h) * 64 + fr)) * 64 + kk * 32 + fq * 8);
        ccur[d][0] = GBt[(d * 2 + 0) * 512 + h * 64 + fr]; ccur[d][1] = GBt[(d * 2 + 1) * 512 + h * 64 + fr]; ccur[d][2] = SPt[d * 512 + h * 64 + fr];
    }
#pragma unroll 2
    for (int cb = 0; cb < 4; ++cb) {
        const int cl = cb * 16 + fr, c = h * 64 + cl, srcl = cb * 16 + fr;
        bf16x8 bnxt[2][2][2]; float cnxt[2][3];
        if (cb < 3) {
            const int cn = cl + 16;
#pragma unroll
            for (int d = 0; d < 2; ++d) {
#pragma unroll
                for (int g = 0; g < 2; ++g)
#pragma unroll
                    for (int kk = 0; kk < 2; ++kk) bnxt[d][g][kk] = *(const bf16x8*)(GW + ((size_t)(((d * 2 + g) * 8 + h) * 64 + cn)) * 64 + kk * 32 + fq * 8);
                cnxt[d][0] = GBt[(d * 2 + 0) * 512 + h * 64 + cn]; cnxt[d][1] = GBt[(d * 2 + 1) * 512 + h * 64 + cn]; cnxt[d][2] = SPt[d * 512 + h * 64 + cn];
            }
        }
        const float v0 = __shfl(w0, srcl), v1 = __shfl(w1, srcl), v2 = __shfl(w2, srcl), v3 = __shfl(w3, srcl), vb = __shfl(wb, srcl);
        const float hcf = __shfl(cf, srcl), hcb = __shfl(cbk, srcl);
        f32x4 acc[2][2][2];
#pragma unroll
        for (int tb = 0; tb < 2; ++tb)
#pragma unroll
            for (int d = 0; d < 2; ++d)
#pragma unroll
                for (int g = 0; g < 2; ++g) acc[tb][d][g] = (f32x4){0.f, 0.f, 0.f, 0.f};
#pragma unroll
        for (int d = 0; d < 2; ++d)
#pragma unroll
            for (int g = 0; g < 2; ++g)
#pragma unroll
                for (int kk = 0; kk < 2; ++kk) {
#pragma unroll
                    for (int tb = 0; tb < 2; ++tb) acc[tb][d][g] = __builtin_amdgcn_mfma_f32_16x16x32_bf16(afr[tb][kk], bcur[d][g][kk], acc[tb][d][g], 0, 0, 0);
                }
        float xc[2][4];
#pragma unroll
        for (int tb = 0; tb < 2; ++tb) { float xr[7];
#pragma unroll
            for (int i = 0; i < 7; ++i) xr[i] = bf2f(XR[(tb * 16 + fq * 4 + i) * 512 + c]);
#pragma unroll
            for (int j = 0; j < 4; ++j) xc[tb][j] = vb + v0 * xr[j] + v1 * xr[j + 1] + v2 * xr[j + 2] + v3 * xr[j + 3]; }
        float hs[2][4];
#pragma unroll
        for (int d = 0; d < 2; ++d) {
            const float br = ccur[d][0], bi = ccur[d][1], sp = ccur[d][2];
            float a[2][4], b[2][4];
#pragma unroll
            for (int tb = 0; tb < 2; ++tb)
#pragma unroll
                for (int j = 0; j < 4; ++j) {
                    const float e1 = __expf(-(acc[tb][d][0][j] + br)), e2 = __expf(-(acc[tb][d][1][j] + bi));
                    const float p1 = 1.0f + e1, p2 = 1.0f + e2, inv = __builtin_amdgcn_rcpf(p1 * p2);
                    const float r = p2 * inv, ig = p1 * inv;
                    const float la = -sp * r, av = __expf(la);
                    const float om = 1.0f - av * av;
                    a[tb][j] = av; b[tb][j] = xc[tb][j] * ig * __builtin_amdgcn_sqrtf(fmaxf(om, 0.f)); }
            float A0, B0, A1, B1;
            if (d == 0) {
                rg_scan_tile<false, PASS == 3>(a[0], b[0], hcf, lane, A0, B0);
                const float hmid = A0 * hcf + B0;
                rg_scan_tile<false, PASS == 3>(a[1], b[1], hmid, lane, A1, B1);
                if (PASS == 1) { if (fq == 0) AGG[((size_t)ci * 2 + 0) * 512 + c] = make_float2(A0 * A1, A1 * B0 + B1); }
                else if (s < 32 && k == nch - 1 && fq == 3) ns[c] = b[1][3];
            } else {
                rg_scan_tile<true, PASS == 3>(a[1], b[1], hcb, lane, A1, B1);
                const float hmid = A1 * hcb + B1;
                rg_scan_tile<true, PASS == 3>(a[0], b[0], hmid, lane, A0, B0);
                if (PASS == 1) { if (fq == 0) AGG[((size_t)ci * 2 + 1) * 512 + c] = make_float2(A1 * A0, A0 * B1 + B0); }
                else if (s < 32 && k == 0 && fq == 0) ns[512 + c] = b[0][0];
            }
            if (PASS == 3) {
#pragma unroll
                for (int tb = 0; tb < 2; ++tb)
#pragma unroll
                    for (int j = 0; j < 4; ++j) hs[tb][j] = d == 0 ? b[tb][j] : hs[tb][j] + b[tb][j];
            }
        }
        if (PASS == 3) {
#pragma unroll
            for (int tb = 0; tb < 2; ++tb)
#pragma unroll
                for (int j = 0; j < 4; ++j) { const int t = tb * 16 + fq * 4 + j;
                    OR[t * 512 + c] = (bf16_t)f2bf(hs[tb][j] * gelu_fast(bf2f(YR[t * 512 + c]))); }
        }
        if (cb < 3) {
#pragma unroll
            for (int d = 0; d < 2; ++d) {
#pragma unroll
                for (int g = 0; g < 2; ++g)
#pragma unroll
                    for (int kk = 0; kk < 2; ++kk) bcur[d][g][kk] = bnxt[d][g][kk];
                ccur[d][0] = cnxt[d][0]; ccur[d][1] = cnxt[d][1]; ccur[d][2] = cnxt[d][2];
            }
        }
    }
    __syncthreads();
    if (PASS == 3) {
        bf16_t* O = (bf16_t*)(p.ws + WS_XN);
        const float* gr = p.in[I_GRNN] + l * 512;
#pragma unroll 1
        for (int q = 0; q < 4; ++q) { const int t = wave * 4 + q;
            const u32x4 v = *(const u32x4*)(OR + t * 512 + lane * 8);
            float f[8] = { bf2f(v.x & 0xffffu), bf2f(v.x >> 16), bf2f(v.y & 0xffffu), bf2f(v.y >> 16), bf2f(v.z & 0xffffu), bf2f(v.z >> 16), bf2f(v.w & 0xffffu), bf2f(v.w >> 16) };
            float ss = 0.f;
#pragma unroll
            for (int e = 0; e < 8; ++e) ss += f[e] * f[e];
            ss = wave_sum(ss);
            const float rstd = rsqrtf(ss * (1.0f / 512.0f) + EPS);
            const f32x4 g0 = *(const f32x4*)(gr + lane * 8), g1 = *(const f32x4*)(gr + lane * 8 + 4);
            u32x4 w; w.x = pk2(f[0] * rstd * g0[0], f[1] * rstd * g0[1]); w.y = pk2(f[2] * rstd * g0[2], f[3] * rstd * g0[3]);
            w.z = pk2(f[4] * rstd * g1[0], f[5] * rstd * g1[1]); w.w = pk2(f[6] * rstd * g1[2], f[7] * rstd * g1[3]);
            *(u32x4*)(O + (size_t)(r0 + t) * 1024 + lane * 8) = w; }
        __syncthreads();
    }
}

#ifndef HD
#define HD __host__ __device__ __forceinline__
#endif
HD int PADX(int i) { return i + (i >> 4); }
constexpr int FFT_N = 8192;
constexpr int FFT_BUF_BYTES = (FFT_N + FFT_N / 16) * 8;
template <int R> struct Log2 { static constexpr int v = 1 + Log2<R / 2>::v; };
template <> struct Log2<1> { static constexpr int v = 0; };
template <int R> HD int bitrev_c(int x) { int r = 0;
#pragma unroll
    for (int i = 0; i < Log2<R>::v; ++i) if (x & (1 << i)) r |= (R >> (i + 1));
    return r; }
HD void twid_unit(int num, int den, float& c, float& s) {
    const float rev = (float)num / (float)den;
#if defined(__HIP_DEVICE_COMPILE__)
    c = __builtin_amdgcn_cosf(rev); s = -__builtin_amdgcn_sinf(rev);
#else
    c = (float)cos(6.283185307179586 * (double)rev); s = -(float)sin(6.283185307179586 * (double)rev);
#endif
}
template <int R> HD void fft_reg(v2f (&v)[R]) {
#pragma unroll
    for (int st = 0; st < Log2<R>::v; ++st) {
        const int half = (R / 2) >> st;
#pragma unroll
        for (int i = 0; i < R; ++i) {
            if ((i & half) == 0) {
                const v2f a = v[i], b = v[i + half];
                v[i] = a + b;
                const v2f d = a - b;
                const int tw = (i & (half - 1)) * (R / (2 * half));
                const v2f ds = __builtin_shufflevector(d, d, 1, 0);
                if (tw == 0) v[i + half] = d;
                else if (tw * 4 == R) v[i + half] = ds * (v2f){1.0f, -1.0f};
                else {
                    const float c = (float)__builtin_cos(6.283185307179586 * (double)tw / (double)R), sn = (float)__builtin_sin(6.283185307179586 * (double)tw / (double)R);
                    v[i + half] = d * (v2f){c, c} + ds * (v2f){sn, -sn};
                }
            }
        }
    }
}
template <int R, int NS> HD void fft_step_load(const float2* buf, int j, v2f (&v)[R]) {
    const v2f* bp = (const v2f*)buf + PADX(j);
#pragma unroll
    for (int r = 0; r < R; ++r) v[r] = bp[r * (FFT_N / R + FFT_N / R / 16)];
    if (NS > 1) {
        const int k = j & (NS - 1);
        float c1, s1; twid_unit(k, NS * R, c1, s1);
        v2f w = (v2f){c1, s1};
        const v2f w1c = (v2f){c1, c1}, w1s = (v2f){-s1, s1};
#pragma unroll
        for (int r = 1; r < R; ++r) {
            const v2f x = v[r], xs = __builtin_shufflevector(x, x, 1, 0);
            const v2f wsn = __builtin_shufflevector(w, w, 1, 1) * (v2f){-1.0f, 1.0f};
            v[r] = x * __builtin_shufflevector(w, w, 0, 0) + xs * wsn;
            w = w * w1c + __builtin_shufflevector(w, w, 1, 0) * w1s;
        }
    }
    fft_reg<R>(v);
}
template <int R, int NS> HD void fft_step_store(float2* buf, int j, const v2f (&v)[R]) {
    const int k = j & (NS - 1);
    const int idxD = (j - k) * R + k;
    v2f* bp = (v2f*)buf + PADX(idxD);
#pragma unroll
    for (int q = 0; q < R; ++q) { const int qq = bitrev_c<R>(q); bp[NS >= 16 ? qq * (NS + NS / 16) : PADX(qq * NS)] = v[q]; }
}
__device__ __forceinline__ void fft8192(float2* buf, int tid) {
    __syncthreads();
    {
        v2f v[32];
        if (tid < 256) fft_step_load<32, 1>(buf, tid, v);
        __syncthreads();
        if (tid < 256) fft_step_store<32, 1>(buf, tid, v);
        __syncthreads();
    }
    {
        v2f v[16];
        int j = tid; asm volatile("" : "+v"(j));
        fft_step_load<16, 32>(buf, j, v);
        __syncthreads();
        fft_step_store<16, 32>(buf, j, v);
        __syncthreads();
    }
    {
        v2f v[16];
        int j = tid; asm volatile("" : "+v"(j));
        fft_step_load<16, 512>(buf, j, v);
        __syncthreads();
        fft_step_store<16, 512>(buf, j, v);
        __syncthreads();
    }
}
template <int ORD> HD void spec_mul(float2* X, const float2* KF, int tid) {
    const int pb = PADX(tid), mb = PADX(FFT_N - tid);
#pragma unroll 2
    for (int j = 0; j < 16; ++j) {
        const int pn = pb + 544 * j, pm = (tid == 0 && j == 0) ? 0 : mb - 544 * j;
        const float2 x = X[pn], zk = KF[pn], zm = KF[pm];
        float kr, ki;
        if (ORD == 0) { kr = 0.5f * (zk.x + zm.x); ki = 0.5f * (zk.y - zm.y); }
        else { kr = 0.5f * (zk.y + zm.y); ki = -0.5f * (zk.x - zm.x); }
        const float yr = x.x * kr - x.y * ki, yi = x.x * ki + x.y * kr;
        X[pn] = make_float2(yr * (1.0f / FFT_N), -yi * (1.0f / FFT_N));
    }
}

struct HyW { float wv0, wv1, wv2, bv, wa0, wa1, wa2, ba, wb0, wb1, wb2, bb, bias0, bias1; };
__device__ __forceinline__ void hyconv16(const bf16_t* row, int t0, int L, float w0, float w1, float w2, float b, float (&o)[16]) {
    const u32x4 a = *(const u32x4*)(row + t0), c = *(const u32x4*)(row + t0 + 8);
    float x[18];
    x[0] = t0 > 0 ? bf2f(row[t0 - 1]) : 0.f;
    x[17] = t0 + 16 < L ? bf2f(row[t0 + 16]) : 0.f;
    x[1] = bf2f(a.x & 0xffffu); x[2] = bf2f(a.x >> 16); x[3] = bf2f(a.y & 0xffffu); x[4] = bf2f(a.y >> 16);
    x[5] = bf2f(a.z & 0xffffu); x[6] = bf2f(a.z >> 16); x[7] = bf2f(a.w & 0xffffu); x[8] = bf2f(a.w >> 16);
    x[9] = bf2f(c.x & 0xffffu); x[10] = bf2f(c.x >> 16); x[11] = bf2f(c.y & 0xffffu); x[12] = bf2f(c.y >> 16);
    x[13] = bf2f(c.z & 0xffffu); x[14] = bf2f(c.z >> 16); x[15] = bf2f(c.w & 0xffffu); x[16] = bf2f(c.w >> 16);
#pragma unroll
    for (int e = 0; e < 16; ++e) o[e] = b + w0 * x[e] + w1 * x[e + 1] + w2 * x[e + 2];
}
template <int PATH>
__device__ __forceinline__ void hy_group(float2* X, const float2* KF, bf16_t* vbase, const HyW& w, int tid, bool dry) {
    constexpr int L = PATH ? 4096 : 256;
    constexpr size_t SSTR = (size_t)1536 * L;
    constexpr size_t CH = (size_t)512 * L;
    const bool act = PATH ? (tid < 256) : ((tid & 31) < 16);
    const int t0 = PATH ? tid * 16 : (tid & 31) * 16;
    bf16_t* r0p = PATH ? vbase : vbase + (size_t)(tid >> 5) * 2 * SSTR;
    float2* xs = X + tid * 17;
    float2 sv[16];
    {
        float o0[16], o1[16];
        if (act) { hyconv16(r0p, t0, L, w.wv0, w.wv1, w.wv2, w.bv, o0); hyconv16(r0p + SSTR, t0, L, w.wv0, w.wv1, w.wv2, w.bv, o1); }
#pragma unroll
        for (int e = 0; e < 16; ++e) { sv[e] = act ? make_float2(o0[e], o1[e]) : make_float2(0.f, 0.f); xs[e] = sv[e]; }
    }
    fft8192(X, tid); spec_mul<0>(X, KF, tid); fft8192(X, tid);
    {
        float o0[16], o1[16];
        if (act) { hyconv16(r0p + CH, t0, L, w.wa0, w.wa1, w.wa2, w.ba, o0); hyconv16(r0p + CH + SSTR, t0, L, w.wa0, w.wa1, w.wa2, w.ba, o1); }
#pragma unroll
        for (int e = 0; e < 16; ++e) { const float2 r = xs[e];
            sv[e] = act ? make_float2(o0[e] * (r.x + w.bias0 * sv[e].x), o1[e] * (-r.y + w.bias0 * sv[e].y)) : make_float2(0.f, 0.f); }
        __syncthreads();
#pragma unroll
        for (int e = 0; e < 16; ++e) xs[e] = sv[e];
    }
    fft8192(X, tid); spec_mul<1>(X, KF, tid); fft8192(X, tid);
    if (act) {
        float o0[16], o1[16];
        hyconv16(r0p + 2 * CH, t0, L, w.wb0, w.wb1, w.wb2, w.bb, o0); hyconv16(r0p + 2 * CH + SSTR, t0, L, w.wb0, w.wb1, w.wb2, w.bb, o1);
        float y0[16], y1[16];
#pragma unroll
        for (int e = 0; e < 16; ++e) { const float2 r = xs[e]; y0[e] = o0[e] * (r.x + w.bias1 * sv[e].x); y1[e] = o1[e] * (-r.y + w.bias1 * sv[e].y); }
        u32x4 p0, p1, q0, q1;
        p0.x = pk2(y0[0], y0[1]); p0.y = pk2(y0[2], y0[3]); p0.z = pk2(y0[4], y0[5]); p0.w = pk2(y0[6], y0[7]);
        p1.x = pk2(y0[8], y0[9]); p1.y = pk2(y0[10], y0[11]); p1.z = pk2(y0[12], y0[13]); p1.w = pk2(y0[14], y0[15]);
        q0.x = pk2(y1[0], y1[1]); q0.y = pk2(y1[2], y1[3]); q0.z = pk2(y1[4], y1[5]); q0.w = pk2(y1[6], y1[7]);
        q1.x = pk2(y1[8], y1[9]); q1.y = pk2(y1[10], y1[11]); q1.z = pk2(y1[12], y1[13]); q1.w = pk2(y1[14], y1[15]);
        if (!dry) { *(u32x4*)(r0p + t0) = p0; *(u32x4*)(r0p + t0 + 8) = p1; *(u32x4*)(r0p + SSTR + t0) = q0; *(u32x4*)(r0p + SSTR + t0 + 8) = q1; }
    }
}
template <int PATH>
__device__ __forceinline__ void hy_filter(float2* KF, const float* T, int c, int tid, int pb) {
    constexpr int L = PATH ? 4096 : 256;
    const float* f0 = T + (size_t)(0 * 1024 + c) * L; const float* b0 = T + (size_t)(0 * 1024 + 512 + c) * L;
    const float* f1 = T + (size_t)(1 * 1024 + c) * L; const float* b1 = T + (size_t)(1 * 1024 + 512 + c) * L;
    __syncthreads();
    for (int j = 0; j < 16; ++j) { const int n = tid + 512 * j; float re = 0.f, im = 0.f;
        if (n < L) { re = __builtin_nontemporal_load(f0 + n); im = __builtin_nontemporal_load(f1 + n); }
        else if (n > FFT_N - L) { const int jj = FFT_N - n; re = __builtin_nontemporal_load(b0 + jj); im = __builtin_nontemporal_load(b1 + jj); }
        KF[pb + 544 * j] = make_float2(re, im); }
    fft8192(KF, tid);
}
__device__ __forceinline__ void hyena_item(CP& p, int l, int c, unsigned char* smem, bool dry) {
    float2* X = (float2*)smem; float2* KF = (float2*)(smem + FFT_BUF_BYTES);
    const int tid = opaque_tid(), pb = PADX(tid);
    bf16_t* PHY = (bf16_t*)(p.ws + WS_PHY);
    const float* TAPS = (const float*)(p.ws + WS_TAPS);
    const float* cw = p.in[I_HYCW] + (size_t)l * 3 * 1536; const float* cb = p.in[I_HYCB] + l * 1536;
    HyW w;
    w.wv0 = cw[c]; w.wv1 = cw[1536 + c]; w.wv2 = cw[3072 + c]; w.bv = cb[c];
    w.wa0 = cw[512 + c]; w.wa1 = cw[1536 + 512 + c]; w.wa2 = cw[3072 + 512 + c]; w.ba = cb[512 + c];
    w.wb0 = cw[1024 + c]; w.wb1 = cw[1536 + 1024 + c]; w.wb2 = cw[3072 + 1024 + c]; w.bb = cb[1024 + c];
    w.bias0 = p.in[I_HYB][(l * 2 + 0) * 512 + c]; w.bias1 = p.in[I_HYB][(l * 2 + 1) * 512 + c];
    hy_filter<0>(KF, TAPS, c, tid, pb);
    hy_group<0>(X, KF, PHY + (size_t)c * 256, w, tid, dry);
    hy_filter<1>(KF, TAPS + TAPS_LAT_OFF, c, tid, pb);
#pragma unroll 1
    for (int g = 0; g < 2; ++g) hy_group<1>(X, KF, PHY + PHY_LAT_OFF + ((size_t)(2 * g) * 1536 + c) * 4096, w, tid, dry);
}
__device__ __forceinline__ void hytrans_item(CP& p, int l, int rt, unsigned char* smem) {
    bf16_t* Tl = (bf16_t*)smem;
    const int tid = opaque_tid(), lane = tid & 63, wave = tid >> 6;
    const bf16_t* PHY = (const bf16_t*)(p.ws + WS_PHY);
    const bf16_t* base; size_t ldc;
    if (rt < 128) { base = PHY + ((size_t)(rt >> 2) * 1536) * 256 + (rt & 3) * 64; ldc = 256; }
    else { const int rl = rt - 128; base = PHY + PHY_LAT_OFF + ((size_t)(rl >> 6) * 1536) * 4096 + (rl & 63) * 64; ldc = 4096; }
    for (int v = tid; v < 512 * 8; v += NTHR) { const int c = v >> 3, q = v & 7;
        const u32x4 d = __builtin_nontemporal_load((const u32x4*)(base + (size_t)c * ldc + q * 8));
        unsigned* dst = (unsigned*)(Tl + c * 66 + q * 8); dst[0] = d.x; dst[1] = d.y; dst[2] = d.z; dst[3] = d.w; }
    __syncthreads();
    bf16_t* O = (bf16_t*)(p.ws + WS_XN);
    const float* gh = p.in[I_GHY] + l * 512;
    const f32x4 g0 = *(const f32x4*)(gh + lane * 8), g1 = *(const f32x4*)(gh + lane * 8 + 4);
#pragma unroll 1
    for (int q = 0; q < 8; ++q) { const int t = wave * 8 + q;
        float f[8]; float ss = 0.f;
#pragma unroll
        for (int e = 0; e < 8; ++e) { f[e] = bf2f(Tl[(lane * 8 + e) * 66 + t]); ss += f[e] * f[e]; }
        ss = wave_sum(ss);
        const float rstd = rsqrtf(ss * (1.0f / 512.0f) + EPS);
        u32x4 w; w.x = pk2(f[0] * rstd * g0[0], f[1] * rstd * g0[1]); w.y = pk2(f[2] * rstd * g0[2], f[3] * rstd * g0[3]);
        w.z = pk2(f[4] * rstd * g1[0], f[5] * rstd * g1[1]); w.w = pk2(f[6] * rstd * g1[2], f[7] * rstd * g1[3]);
        *(u32x4*)(O + (size_t)(rt * 64 + t) * 1024 + 512 + lane * 8) = w; }
    __syncthreads();
}

__device__ __forceinline__ void cg_load_row(const bf16_t* Gb, int rtx, int n_r, int cb, int tid, u32x4 (&vals)[5]) {
    const int cvf = tid & 31, sl = tid >> 5;
    const bool ctx = rtx < 128; const int q = rtx & 3;
#pragma unroll
    for (int i = 0; i < 5; ++i) {
        const int slot = sl + 16 * i, tok = slot - 1;
        bool ok = ctx ? ((tok >= 0 || q > 0) && (tok < 64 || q < 3)) : (tok >= 0 && tok < 64);
        if (i == 4 && sl >= 2) ok = false;
        vals[i] = (u32x4){0u, 0u, 0u, 0u};
        if (ok) vals[i] = __builtin_nontemporal_load((const u32x4*)(Gb + (size_t)((long)rtx * 64 + tok) * n_r + cb * 256 + cvf * 8));
    }
}
__device__ __forceinline__ void cg_store_row(bf16_t* Tl, int rtx, int tid, const u32x4 (&vals)[5]) {
    const int cvf = tid & 31, sl = tid >> 5; bf16_t* base = Tl + (size_t)(rtx % 3) * (66 * 256);
#pragma unroll
    for (int i = 0; i < 5; ++i) { const int slot = sl + 16 * i; if (i < 4 || sl < 2) *(u32x4*)(base + (size_t)slot * 256 + cvf * 8) = vals[i]; }
}
__device__ __forceinline__ void phase_convgate(CP& p, int l, int ntile, int n_r, int ch0, unsigned char* smem) {
    bf16_t* Tl = (bf16_t*)smem;
    const int tid = opaque_tid();
    const bf16_t* Gb = (const bf16_t*)(p.ws + WS_FG);
    bf16_t* Ab = (bf16_t*)(p.ws + WS_FA);
    const int G = gridDim.x, bid = blockIdx.x;
    const int cb = bid % ntile, idx = bid / ntile, nb = (G - cb + ntile - 1) / ntile, per = (384 + nb - 1) / nb;
    const int rt_lo = idx * per, rt_hi = (rt_lo + per < 384) ? rt_lo + per : 384;
    if (rt_lo >= rt_hi) return;
    const int cv = tid & 31, tg = tid >> 5;
    const int chl = cb * 256 + cv * 8, chg = ch0 + chl;
    const float* cw = p.in[I_FCW] + (size_t)l * 9 * DFF; const float* cbv = p.in[I_FCB] + l * DFF;
    f32x4 wt[9][2];
#pragma unroll
    for (int t9 = 0; t9 < 9; ++t9) { wt[t9][0] = *(const f32x4*)(cw + (size_t)t9 * DFF + chg); wt[t9][1] = *(const f32x4*)(cw + (size_t)t9 * DFF + chg + 4); }
    float bias[8];
    { const f32x4 b0 = *(const f32x4*)(cbv + chg), b1 = *(const f32x4*)(cbv + chg + 4); bias[0] = b0[0]; bias[1] = b0[1]; bias[2] = b0[2]; bias[3] = b0[3]; bias[4] = b1[0]; bias[5] = b1[1]; bias[6] = b1[2]; bias[7] = b1[3]; }
    {
        u32x4 v0[5], v1[5], v2[5];
        if (rt_lo > 0) cg_load_row(Gb, rt_lo - 1, n_r, cb, tid, v0);
        cg_load_row(Gb, rt_lo, n_r, cb, tid, v1);
        if (rt_lo + 1 < 384) cg_load_row(Gb, rt_lo + 1, n_r, cb, tid, v2);
        if (rt_lo > 0) cg_store_row(Tl, rt_lo - 1, tid, v0);
        cg_store_row(Tl, rt_lo, tid, v1);
        if (rt_lo + 1 < 384) cg_store_row(Tl, rt_lo + 1, tid, v2);
    }
    __syncthreads();
#pragma unroll 1
    for (int rt = rt_lo; rt < rt_hi; ++rt) {
        const bool ctx = rt < 128; const int gr = (rt - 128) & 63, r0 = rt * 64;
        const bool pre = (rt + 2 < 384) && (rt + 1 < rt_hi);
        u32x4 nx[5];
        if (pre) cg_load_row(Gb, rt + 2, n_r, cb, tid, nx);
        u32x4 av4[4];
#pragma unroll
        for (int tt = 0; tt < 4; ++tt) av4[tt] = __builtin_nontemporal_load((const u32x4*)(Ab + (size_t)(r0 + tg * 4 + tt) * n_r + chl));
        v2f acc[4][4];
#pragma unroll
        for (int tt = 0; tt < 4; ++tt)
#pragma unroll
            for (int e = 0; e < 4; ++e) acc[tt][e] = (v2f){bias[2 * e], bias[2 * e + 1]};
#pragma unroll
        for (int dy = 0; dy < 3; ++dy) {
            if (dy == 0 && (ctx || gr == 0)) continue;
            if (dy == 2 && (ctx || gr == 63)) continue;
            const bf16_t* rowb = Tl + (size_t)((rt + dy + 2) % 3) * (66 * 256);
#pragma unroll
            for (int dx = 0; dx < 3; ++dx) {
                const f32x4 w0 = wt[dy * 3 + dx][0], w1 = wt[dy * 3 + dx][1];
                const v2f wa = (v2f){w0[0], w0[1]}, wb = (v2f){w0[2], w0[3]}, wc2 = (v2f){w1[0], w1[1]}, wd = (v2f){w1[2], w1[3]};
#pragma unroll
                for (int tt = 0; tt < 4; ++tt) { const int col = tg * 4 + tt;
                    const u32x4 d = *(const u32x4*)(rowb + (size_t)(col + dx) * 256 + cv * 8);
                    acc[tt][0] += wa * (v2f){__uint_as_float(d.x << 16), __uint_as_float(d.x & 0xffff0000u)};
                    acc[tt][1] += wb * (v2f){__uint_as_float(d.y << 16), __uint_as_float(d.y & 0xffff0000u)};
                    acc[tt][2] += wc2 * (v2f){__uint_as_float(d.z << 16), __uint_as_float(d.z & 0xffff0000u)};
                    acc[tt][3] += wd * (v2f){__uint_as_float(d.w << 16), __uint_as_float(d.w & 0xffff0000u)}; }
            }
        }
#pragma unroll
        for (int tt = 0; tt < 4; ++tt) { const size_t off = (size_t)(r0 + tg * 4 + tt) * n_r + chl;
            const u32x4 a = av4[tt];
            float av[8]; unpack8(a, av);
            float hv[8];
#pragma unroll
            for (int e = 0; e < 8; ++e) hv[e] = gelu_fast(acc[tt][e >> 1][e & 1]) * av[e];
            u32x4 w; w.x = pk2(hv[0], hv[1]); w.y = pk2(hv[2], hv[3]); w.z = pk2(hv[4], hv[5]); w.w = pk2(hv[6], hv[7]);
            *(u32x4*)(Ab + off) = w; }
        __syncthreads();
        if (pre) cg_store_row(Tl, rt + 2, tid, nx);
        __syncthreads();
    }
}

#ifndef NO_MEGA
__global__ void __launch_bounds__(NTHR, 2) mega_fwd(P p) {
    extern __shared__ __attribute__((aligned(16))) unsigned char smem[];
    cg::grid_group grid = cg::this_grid();
    const int G = gridDim.x, bid = blockIdx.x;
    LAS unsigned char* lds = (LAS unsigned char*)smem;
    CP* kp = (CP*)__builtin_amdgcn_kernarg_segment_ptr();
    unsigned char* ws = p.ws;
#define PQ (*opq(kp))

    volatile LAS unsigned* bst = (volatile LAS unsigned*)(lds + LDS_BYTES - 16);
    if (threadIdx.x < 2) bst[threadIdx.x] = 0u;
    __syncthreads();
    const XcdBarrier xbar = xcd_barrier_post((unsigned*)(ws + WS_BAR), bst);
#define GSYNC() xcd_barrier(xbar)
#define MULT(k) (1 + ((PROBE_MASK >> (k)) & 1))
#define REP(k) _Pragma("unroll 1") for (int rep = (PROBE_MASK >> (k)) & 1; rep >= 0; --rep)
#ifndef SKIP_MASK
#define SKIP_MASK 0
#endif
#ifndef NRUN
#define NRUN 1
#endif
#pragma unroll 1
    for (int run = 0; run < NRUN; ++run) {
    const int skipm = (NRUN == 2 && run == 0) ? SKIP_MASK : 0;
#define SK(k) ((skipm >> (k)) & 1)
    if (!SK(0)) REP(0) {
        phase_mod(PQ, smem);
        __syncthreads();
        phase_h2(PQ, smem);
    }
    GSYNC();
    if (PQ.ws == nullptr) grid.sync();

#pragma unroll 1
    for (int l = 0; l < 2; ++l) {
        const float* MODl = (const float*)(ws + WS_MOD) + (size_t)l * 5 * 6144;
        if (!SK(1)) REP(1) phase_wconv(PQ, l, 0, l == 0 ? 896 : 0, bid, G, true, smem);
        if (!SK(2)) REP(2) phase_norm(PQ, l, 0);
        if (!SK(3)) REP(3) phase_taps(PQ, l, smem);
        GSYNC();
        if (!SK(4)) REP(4) {
            SchedWin S; S.init(96, 10, G, bid); S.XN = (const char*)(ws + WS_XN); S.W = (const char*)(ws + WS_WIN); S.tstep = (size_t)256 * 1024 * 2;
            EpiWin E{(bf16_t*)(ws + WS_PRG), (bf16_t*)(ws + WS_PHY)};
            pg8::gemm_phase(lds, 1024, S, E);
        }
        GSYNC();
        if (!SK(5)) for (int c = bid; c < 512 * MULT(5); c += G) hyena_item(PQ, l, c & 511, smem, MULT(5) == 2 && c < 512);
        __syncthreads();
        if (!SK(6)) for (int ci = bid; ci < 768 * MULT(6); ci += G) rg_item<1>(PQ, l, ci % 768, smem);
        GSYNC();
        if (!SK(7)) for (int ci = bid; ci < 768 * MULT(7); ci += G) rg_item<3>(PQ, l, ci % 768, smem);
        if (!SK(8)) for (int rt = bid; rt < 384 * MULT(8); rt += G) hytrans_item(PQ, l, rt % 384, smem);
        GSYNC();
        if (!SK(9)) REP(9) {
            SchedStd S; S.init(96, 4, G, bid); S.A = (const char*)(ws + WS_XN); S.B = (const char*)(ws + WS_WOUT); S.tstep = (size_t)256 * 1024 * 2;
            if (l == 0) { EpiResT<true> E; E.xin_ctx = p.in[I_XP]; E.xin_lat = p.in[I_XS] - (size_t)NCTX * 1024; E.xin_b = nullptr; E.out_b = (bf16_t*)p.out; E.gate = MODl + 2048; E.dry = rep == 1;
                pg8::gemm_phase(lds, 1024, S, E); }
            else { EpiResT<false> E; E.xin_ctx = nullptr; E.xin_lat = nullptr; E.xin_b = (const bf16_t*)p.out; E.out_b = (bf16_t*)p.out; E.gate = MODl + 2048; E.dry = rep == 1;
                pg8::gemm_phase(lds, 1024, S, E); }
        }
        const int idle_lo = (G < 384 && G >= 192) ? 384 - G : 0, nidle = G - idle_lo;
        if (bid >= idle_lo && !SK(1)) {
            phase_wconv(PQ, l, 896, 1664, bid - idle_lo, nidle, false, smem);
            phase_wconv(PQ, l, 2304, 2688, bid - idle_lo, nidle, false, smem);
        }
        GSYNC();
        if (!SK(10)) REP(10) phase_norm(PQ, l, 1);
        GSYNC();
#pragma unroll 1
        for (int r = 0; r < 2; ++r) {
            const int n_r = r ? FF_N1 : FF_N0, ntile = n_r / 256, ch0 = r ? FF_N0 : 0;
            if (!SK(11)) REP(11) {
                SchedStd S; S.init(96, 2 * ntile, G, bid); S.A = (const char*)(ws + WS_XN); S.B = (const char*)(ws + WS_WUP) + (r ? (size_t)3072 * 1024 * 2 : 0); S.tstep = (size_t)256 * 1024 * 2;
                EpiUp E{(bf16_t*)(ws + WS_FA), (bf16_t*)(ws + WS_FG), ntile, n_r};
                pg8::gemm_phase(lds, 1024, S, E);
            }
            GSYNC();
            if (!SK(12)) phase_convgate(PQ, l, ntile, n_r, ch0, smem);
            GSYNC();
            if (!SK(13)) REP(13) {
                SchedStd S; S.init(96, 4, G, bid); S.A = (const char*)(ws + WS_FA); S.B = (const char*)(ws + (r ? WS_WDN1 : WS_WDN0)); S.tstep = (size_t)256 * n_r * 2;
                EpiResT<false> E; E.xin_ctx = nullptr; E.xin_lat = nullptr; E.xin_b = (const bf16_t*)p.out;
                E.out_b = (l == 1 && r == 1) ? (bf16_t*)(ws + WS_XN) : (bf16_t*)p.out;
                E.gate = MODl + 5120; E.dry = rep == 1;
                pg8::gemm_phase(lds, n_r, S, E);
            }
            if (bid >= idle_lo && !SK(1)) {
                if (r == 0) { phase_wconv(PQ, l, 1664, 2304, bid - idle_lo, nidle, false, smem); phase_wconv(PQ, l, 2688, 3008, bid - idle_lo, nidle, false, smem); }
                else if (l == 0) phase_wconv(PQ, 1, 0, 896, bid - idle_lo, nidle, false, smem);
            }
            GSYNC();
        }
    }
#if PROBE_MASK
    if (PROBE_MASK & (1 << 15)) { for (int i = 0; i < 20; ++i) GSYNC(); }
#endif
    if (!SK(14)) phase_final_norm(PQ);
    if (NRUN == 2) GSYNC();
    }
#undef SK
#undef REP
#undef PQ
#undef GSYNC
#undef MULT
}

extern "C" void kernel_launch(void* const* d_in, const int* in_sizes, int n_in, void* d_out, int out_size, void* d_ws, size_t ws_size, hipStream_t stream) {
    static int grid = 0;
    if (grid == 0) {
        if (n_in != 32 || ws_size < WS_END) { fprintf(stderr, "kernel_launch: unexpected n_in %d or ws_size %zu (need %zu)\n", n_in, ws_size, (size_t)WS_END); grid = -1; return; }
        int dev = 0, cus = 0, per_cu = 0;
        (void)hipGetDevice(&dev);
        (void)hipDeviceGetAttribute(&cus, hipDeviceAttributeMultiprocessorCount, dev);
        if (hipFuncSetAttribute((const void*)mega_fwd, hipFuncAttributeMaxDynamicSharedMemorySize, LDS_BYTES) != hipSuccess) { fprintf(stderr, "kernel_launch: hipFuncSetAttribute failed\n"); grid = -1; return; }
        if (hipOccupancyMaxActiveBlocksPerMultiprocessor(&per_cu, (const void*)mega_fwd, NTHR, LDS_BYTES) != hipSuccess || per_cu < 1) { fprintf(stderr, "kernel_launch: occupancy query says %d blocks/CU\n", per_cu); per_cu = 1; }
        (void)hipGetLastError();
        grid = cus > 0 ? cus : 256;
    }
    if (grid < 0) return;
    P p{};
    for (int i = 0; i < 32; ++i) p.in[i] = (const float*)d_in[i];
    p.out = (float*)d_out; p.ws = (unsigned char*)d_ws; p.dup_mask = PROBE_MASK;
    (void)hipMemsetAsync((char*)d_ws + WS_BAR, 0, WS_BAR_BYTES, stream);
    void* args[] = {&p};
    hipError_t e = hipLaunchCooperativeKernel((const void*)mega_fwd, dim3(grid), dim3(NTHR), args, LDS_BYTES, stream);
    if (e != hipSuccess) fprintf(stderr, "kernel_launch: cooperative launch failed: %s (grid %d)\n", hipGetErrorString(e), grid);
}
#endif
```

```cpp
#define PROBE_MASK 0
#include <hip/hip_runtime.h>
#include <hip/hip_cooperative_groups.h>
#include <cstdio>
namespace cg = cooperative_groups;

#define LAS __attribute__((address_space(3)))
typedef unsigned short bf16_t;
typedef short bf16x8 __attribute__((ext_vector_type(8)));
typedef float f32x4 __attribute__((ext_vector_type(4)));
typedef unsigned u32x4 __attribute__((ext_vector_type(4)));
typedef unsigned u32x2 __attribute__((ext_vector_type(2)));
typedef float v2f __attribute__((ext_vector_type(2)));

constexpr int DM = 1024, NCTX = 8192, NLAT = 16384, MTOK = 24576, DRNN = 512, DIN = 2560, DFF = 2816;
constexpr int NTHR = 512;
constexpr int FF_N0 = 1536, FF_N1 = 1280;
constexpr float EPS = 1e-6f;

constexpr size_t AL(size_t x) { return (x + 255) & ~(size_t)255; }
constexpr size_t WS_BAR  = 0;
constexpr size_t WS_BAR_BYTES = 16384;
constexpr size_t WS_SP   = WS_BAR_BYTES;
constexpr size_t WS_MOD  = AL(WS_SP + 2 * 2 * 512 * 4);
constexpr size_t WS_H2   = AL(WS_MOD + 2 * 5 * 6144 * 4);
constexpr size_t WS_H2B  = AL(WS_H2 + 2 * 4352 * 64 * 4);
constexpr size_t WS_W3T  = AL(WS_H2B + 2 * 4352 * 64 * 2);
constexpr size_t WS_GW   = AL(WS_W3T + 2 * 2048 * 64 * 2);
constexpr size_t WS_AGG  = AL(WS_GW + 131072 * 2);
constexpr size_t WS_WIN  = AL(WS_AGG + (size_t)768 * 2 * 512 * 8);
constexpr size_t WS_WOUT = AL(WS_WIN + (size_t)2560 * 1024 * 2);
constexpr size_t WS_WUP  = AL(WS_WOUT + (size_t)1024 * 1024 * 2);
constexpr size_t WS_WDN0 = AL(WS_WUP + (size_t)5632 * 1024 * 2);
constexpr size_t WS_WDN1 = AL(WS_WDN0 + (size_t)1024 * 1536 * 2);
constexpr size_t WS_XN   = AL(WS_WDN1 + (size_t)1024 * 1280 * 2);
constexpr size_t WS_BIG  = AL(WS_XN + (size_t)MTOK * 1024 * 2);
constexpr size_t WS_PRG  = WS_BIG;
constexpr size_t WS_PHY  = AL(WS_PRG + (size_t)MTOK * 1024 * 2);
constexpr size_t PHY_LAT_OFF = (size_t)32 * 1536 * 256;
constexpr size_t WS_TAPS = AL(WS_PHY + (size_t)MTOK * 1536 * 2);
constexpr size_t TAPS_LAT_OFF = (size_t)2048 * 256;
constexpr size_t WS_MIX_END = AL(WS_TAPS + ((size_t)2048 * 256 + (size_t)2048 * 4096) * 4);
constexpr size_t WS_FA   = WS_BIG;
constexpr size_t WS_FG   = AL(WS_FA + (size_t)MTOK * FF_N0 * 2);
constexpr size_t WS_FFN_END = AL(WS_FG + (size_t)MTOK * FF_N0 * 2);
constexpr size_t WS_END  = WS_MIX_END > WS_FFN_END ? WS_MIX_END : WS_FFN_END;

constexpr int LDS_BYTES = 140 * 1024;

#ifndef PROBE_MASK
#define PROBE_MASK 0
#endif
struct P {
    const float* in[32];
    float* out;
    unsigned char* ws;
    int dup_mask; int pad;
};
typedef const __attribute__((address_space(4))) P CP;
__device__ __forceinline__ CP* opq(CP* q) { asm volatile("" : "+s"(q)); return q; }
enum { I_XP = 0, I_XS, I_ST, I_C, I_CCTX, I_WADA, I_BADA, I_GN1, I_GN2, I_WIN, I_RGCW, I_RGCB, I_RGGW, I_RGGB, I_RGA, I_HYCW, I_HYCB,
       I_HFW1, I_HFB1, I_HFW2, I_HFB2, I_HFW3, I_HFFR, I_HYB, I_GRNN, I_GHY, I_WOUT, I_WUP, I_FCW, I_FCB, I_WDN, I_GFIN };

__device__ __forceinline__ float bf2f(unsigned b) { return __uint_as_float(b << 16); }
__device__ __forceinline__ unsigned f2bf(float f) { unsigned u = __float_as_uint(f); return (u + 0x7fffu + ((u >> 16) & 1u)) >> 16; }
__device__ __forceinline__ unsigned pk2(float lo, float hi) { unsigned r; asm volatile("v_cvt_pk_bf16_f32 %0, %1, %2" : "=v"(r) : "v"(lo), "v"(hi)); return r; }
__device__ __forceinline__ float sigmoidf_(float x) { return 1.0f / (1.0f + __expf(-x)); }
__device__ __forceinline__ float gelu_tanh(float x) {
    const float u = 0.7978845608028654f * (x + 0.044715f * x * x * x);
    const float e = __expf(2.0f * u);
    const float t = 1.0f - 2.0f / (1.0f + e);
    return 0.5f * x * (1.0f + t);
}
__device__ __forceinline__ float gelu_fast(float x) {
    const float x2 = x * x;
    const float t = x * (-2.302208198f - 0.1029432397f * x2);
    return x * __builtin_amdgcn_rcpf(1.0f + __builtin_amdgcn_exp2f(t));
}
__device__ __forceinline__ float wave_sum(float v) {
#pragma unroll
    for (int o = 32; o >= 1; o >>= 1) v += __shfl_xor(v, o);
    return v;
}
__device__ __forceinline__ int opaque_tid() { int t = threadIdx.x; asm volatile("" : "+v"(t)); return t; }
__device__ __forceinline__ int mod_row(int row) { return row < NCTX ? 0 : 1 + ((row - NCTX) >> 12); }

#define XB_TMO      128
#define XB_XCNT(j)  (256  + 64 * (j))
#define XB_XSUB(j)  (1280 + 64 * (j))
#define XB_XGEN(j)  (2304 + 64 * (j))
#define XB_TOP      3328
#define XB_TOPGEN   3392
#define XCD_BAR_WORDS 3456
#define XB_SPIN_CAP (1u << 18)

__device__ __forceinline__ unsigned xb_ld(unsigned* p)              { return __hip_atomic_load(p, __ATOMIC_RELAXED, __HIP_MEMORY_SCOPE_AGENT); }
__device__ __forceinline__ unsigned xb_add(unsigned* p, unsigned v) { return __hip_atomic_fetch_add(p, v, __ATOMIC_RELAXED, __HIP_MEMORY_SCOPE_AGENT); }
__device__ __forceinline__ unsigned xb_xcc_id() { return (unsigned)__builtin_amdgcn_s_getreg((3 << 11) | 20) & 0xFu; }
#define XB_SPIN(cond, bar) do { unsigned _sp = 0; while (cond) { __builtin_amdgcn_s_sleep(1); \
    if ((++_sp & 255u) == 0u) { if (xb_ld(&(bar)[XB_TMO])) break; if (_sp > XB_SPIN_CAP) { atomicAdd(&(bar)[XB_TMO], 1u); break; } } } } while (0)

struct XcdBarrier {
    unsigned* bar; unsigned x;
    volatile LAS unsigned* st;
};

__device__ __forceinline__ XcdBarrier xcd_barrier_post(unsigned* bar, volatile LAS unsigned* st) {
    XcdBarrier b; b.bar = bar; b.x = xb_xcc_id(); b.st = st;
    if (threadIdx.x == 0) (void)xb_add(&bar[XB_XCNT(b.x)], 1u);
    return b;
}
__device__ __forceinline__ void xcd_barrier_complete(unsigned* bar, unsigned x, unsigned& nloc, unsigned& nx) {
    const unsigned G = gridDim.x * gridDim.y * gridDim.z;
    unsigned sum, cnt, mine, sp = 0u;
    for (;;) {
        sum = 0u; cnt = 0u; mine = 0u;
#pragma unroll
        for (unsigned j = 0; j < 16; ++j) { const unsigned c = xb_ld(&bar[XB_XCNT(j)]); sum += c; cnt += (c > 0u) ? 1u : 0u; mine = (j == x) ? c : mine; }
        if (sum == G) break;
        __builtin_amdgcn_s_sleep(1);
        if ((++sp & 255u) == 0u) { if (xb_ld(&bar[XB_TMO])) break; if (sp > XB_SPIN_CAP) { atomicAdd(&bar[XB_TMO], 1u); break; } }
    }
    nloc = mine > 0u ? mine : 1u; nx = cnt > 0u ? cnt : 1u;
}

__device__ __forceinline__ void xcd_barrier(const XcdBarrier& b) {
    asm volatile("s_waitcnt vmcnt(0)" ::: "memory");
    __syncthreads();
    if (threadIdx.x == 0) {
        unsigned* bar = b.bar;
        __builtin_amdgcn_s_waitcnt(0);
        unsigned nloc = b.st[0], nx = b.st[1];
        if (nloc == 0u) { xcd_barrier_complete(bar, b.x, nloc, nx); b.st[0] = nloc; b.st[1] = nx; }
        const unsigned old = xb_add(&bar[XB_XSUB(b.x)], 1u);
        const unsigned gen = old / nloc;
        if (old + 1u == (gen + 1u) * nloc) {
            __builtin_amdgcn_fence(__ATOMIC_RELEASE, "agent");
            asm volatile("s_waitcnt vmcnt(0)" ::: "memory");
            const unsigned og = xb_add(&bar[XB_TOP], 1u);
            const unsigned tg = og / nx;
            if (og + 1u == (tg + 1u) * nx) xb_add(&bar[XB_TOPGEN], 1u);
            else XB_SPIN(xb_ld(&bar[XB_TOPGEN]) == tg, bar);
            __builtin_amdgcn_fence(__ATOMIC_ACQUIRE, "agent");
            xb_add(&bar[XB_XGEN(b.x)], 1u);
            asm volatile("s_waitcnt vmcnt(0)" ::: "memory");
        } else {
            XB_SPIN(xb_ld(&bar[XB_XGEN(b.x)]) == gen, bar);
            __builtin_amdgcn_fence(__ATOMIC_ACQUIRE, "agent");
            asm volatile("s_waitcnt vmcnt(0)" ::: "memory");
        }
    }
    __syncthreads();
}

namespace pg8 {
constexpr int BM = 256, BK = 64, HALF = 128, HTB = HALF * BK * 2, STAGE_BYTES = 8 * HTB, NXCD = 8, WGM = 8;
__device__ __forceinline__ int lds_byte(int r, int c) { const int st = (r >> 4) * 2 + (c >> 5), rr = r & 15, cc = c & 31, ob = rr * 64 + cc * 2; return st * 1024 + (ob ^ (((ob >> 9) & 1) << 5)); }
__device__ __forceinline__ void stage_rc(int b, int& R, int& C) { const int st = b / 1024, sb = b % 1024, swz = sb ^ (((sb >> 9) & 1) << 5); R = (st >> 1) * 16 + swz / 64; C = (st & 1) * 32 + (swz % 64) / 2; }
__device__ __forceinline__ int perm32(int rho) { const int n = rho >> 4, i = rho & 15; return 8 * (i >> 2) + 4 * n + (i & 3); }
struct Unit { int pm, pn; };
struct TileOrder {
    int nM, nN, nwg, G, c;
    __device__ void init(int nM_, int nN_, int G_, int c_) { nM = nM_; nN = nN_; nwg = nM * nN; G = G_; c = c_; }
    __device__ bool next(int i, Unit& u) const {
        const long L = (long)i * G + c; if (L >= nwg) return false;
        int wgid = (int)L; { const int q = nwg / NXCD, r = nwg % NXCD, xcd = wgid % NXCD, off = wgid / NXCD; wgid = (xcd < r ? xcd * (q + 1) : r * (q + 1) + (xcd - r) * q) + off; }
        const int nig = WGM * nN, gid = wgid / nig, fm = gid * WGM, gsz = (nM - fm) < WGM ? (nM - fm) : WGM;
        u.pm = fm + ((wgid % nig) % gsz); u.pn = (wgid % nig) / gsz; return true;
    }
};
__device__ __forceinline__ unsigned cvt_pk_bf16(float lo, float hi) { unsigned r; asm volatile("v_cvt_pk_bf16_f32 %0, %1, %2" : "=v"(r) : "v"(lo), "v"(hi)); return r; }

template <class Epi, class Sched, bool ALIGN_EPI = true, bool SP2 = true>
__device__ __forceinline__ void gemm_phase(LAS unsigned char* lds, const int K, const Sched& S, const Epi& E) {
    const int tid = opaque_tid(), wid = __builtin_amdgcn_readfirstlane(tid >> 6), lane = tid & 63, wr = wid >> 2, wc = wid & 3, fr = lane & 15, fq = lane >> 4;
    const int nt = K / BK;
    unsigned voffA[2], voffB[2];
#pragma unroll
    for (int i = 0; i < 2; ++i) { int R, C; stage_rc(tid * 16 + i * 8192, R, C); const int Rb = Epi::PERM ? ((R & ~31) + perm32(R & 31)) : R;
        voffA[i] = (unsigned)(R * K + C) * 2u; voffB[i] = (unsigned)(Rb * K + C) * 2u; }
    const size_t kstep = (size_t)(BK * 2);
    const size_t hstep = (size_t)HALF * K * 2;
    const unsigned ldsw = (unsigned)wid * 1024u;
    const int aoff = lds_byte(wr * 64 + fr, fq * 8), boff = lds_byte(wc * 32 + fr, fq * 8);
#define PG8_SA(b, h) (((b) * 2 + (h)) * HTB)
#define PG8_SB(b, h) ((4 + (b) * 2 + (h)) * HTB)
#define PG8_STAGE(bufoff, gbase, voff) do { _Pragma("unroll") for (int _i = 0; _i < 2; ++_i) \
        __builtin_amdgcn_global_load_lds((const unsigned*)((const char*)(gbase) + (voff)[_i]), (LAS unsigned*)(lds + (bufoff) + ldsw + _i * 8192), 16, 0, 0); } while (0)
#define PG8_LDA(dst, b, h) do { _Pragma("unroll") for (int m = 0; m < 4; ++m) _Pragma("unroll") for (int k = 0; k < 2; ++k) dst[m][k] = *(const LAS bf16x8*)(lds + PG8_SA(b, h) + aoff + m * 2048 + k * 1024); } while (0)
#define PG8_LDB(dst, b, h) do { _Pragma("unroll") for (int n = 0; n < 2; ++n) _Pragma("unroll") for (int k = 0; k < 2; ++k) dst[n][k] = *(const LAS bf16x8*)(lds + PG8_SB(b, h) + boff + n * 2048 + k * 1024); } while (0)
#define PG8_MMA(ai, bj, At, Bt) do { __builtin_amdgcn_s_setprio(1); _Pragma("unroll") for (int m = 0; m < 4; ++m) _Pragma("unroll") for (int n = 0; n < 2; ++n) _Pragma("unroll") for (int k = 0; k < 2; ++k) \
        acc[ai][bj][m][n] = __builtin_amdgcn_mfma_f32_16x16x32_bf16(Bt[n][k], At[m][k], acc[ai][bj][m][n], 0, 0, 0); __builtin_amdgcn_s_setprio(0); } while (0)
#define PG8_WAIT_V(n) asm volatile("s_waitcnt vmcnt(" #n ")" ::: "memory")
#define PG8_WAIT_L(n) asm volatile("s_waitcnt lgkmcnt(" #n ")" ::: "memory")
#define PG8_BAR __builtin_amdgcn_s_barrier()
#define PG8_SCHED __builtin_amdgcn_sched_barrier(0)
    Unit cur, nxt; int ui = 0;
    if (!S.next(0, cur)) return;
    f32x4 acc[2][2][4][2];
#pragma unroll
    for (int a = 0; a < 2; ++a)
#pragma unroll
        for (int b = 0; b < 2; ++b)
#pragma unroll
            for (int m = 0; m < 4; ++m)
#pragma unroll
                for (int n = 0; n < 2; ++n) acc[a][b][m][n] = (f32x4){0.f, 0.f, 0.f, 0.f};
    bf16x8 At[4][2], B0[2][2], B1[2][2];
    const char* cA = S.a_base(cur); const char* cB = S.b_base(cur);
    if constexpr (SP2) {
        PG8_STAGE(PG8_SB(0, 0), cB, voffB); PG8_STAGE(PG8_SB(0, 1), cB + hstep, voffB); PG8_STAGE(PG8_SA(0, 0), cA, voffA); PG8_STAGE(PG8_SA(0, 1), cA + hstep, voffA);
        if (wr == 1) PG8_BAR;
        PG8_WAIT_V(2); PG8_BAR;
        PG8_STAGE(PG8_SB(1, 0), cB + kstep, voffB); PG8_STAGE(PG8_SA(1, 0), cA + kstep, voffA); PG8_STAGE(PG8_SB(1, 1), cB + hstep + kstep, voffB);
        PG8_WAIT_V(6); PG8_BAR;
    } else {
        PG8_STAGE(PG8_SB(0, 0), cB, voffB); PG8_STAGE(PG8_SA(0, 0), cA, voffA); PG8_STAGE(PG8_SB(0, 1), cB + hstep, voffB); PG8_STAGE(PG8_SA(0, 1), cA + hstep, voffA);
        if (wr == 1) PG8_BAR;
        PG8_WAIT_V(4); PG8_BAR;
        PG8_STAGE(PG8_SB(1, 0), cB + kstep, voffB); PG8_STAGE(PG8_SA(1, 0), cA + kstep, voffA); PG8_STAGE(PG8_SB(1, 1), cB + hstep + kstep, voffB);
        PG8_WAIT_V(6); PG8_BAR;
    }
    for (;;) {
        const bool has_next = S.next(ui + 1, nxt);
        const char* nA = has_next ? S.a_base(nxt) : cA; const char* nB = has_next ? S.b_base(nxt) : cB;
        for (int t = 0; t < nt; t += 2) {
            const bool last = (t == nt - 2);
            const char* a1 = cA + (size_t)(t + 1) * kstep;
            const char* a2 = last ? nA : cA + (size_t)(t + 2) * kstep; const char* b2 = last ? nB : cB + (size_t)(t + 2) * kstep;
            const char* a3 = a2 + kstep; const char* b3 = b2 + kstep;
            if constexpr (SP2) {
            PG8_LDB(B0, 0, 0); PG8_LDB(B1, 0, 1); PG8_SCHED; PG8_LDA(At, 0, 0); PG8_STAGE(PG8_SA(1, 1), a1 + hstep, voffA);
            PG8_WAIT_V(8); PG8_WAIT_L(0); PG8_BAR; PG8_MMA(0, 0, At, B0); PG8_MMA(0, 1, At, B1); PG8_BAR; PG8_SCHED;
            PG8_LDA(At, 0, 1); PG8_STAGE(PG8_SB(0, 0), b2, voffB); PG8_STAGE(PG8_SB(0, 1), b2 + hstep, voffB); PG8_STAGE(PG8_SA(0, 0), a2, voffA);
            PG8_WAIT_V(8); PG8_WAIT_L(0); PG8_BAR; PG8_MMA(1, 0, At, B0); PG8_MMA(1, 1, At, B1); PG8_BAR; PG8_SCHED;
            PG8_LDB(B0, 1, 0); PG8_LDB(B1, 1, 1); PG8_SCHED; PG8_LDA(At, 1, 0); PG8_STAGE(PG8_SA(0, 1), a2 + hstep, voffA);
            PG8_WAIT_V(8); PG8_WAIT_L(0); PG8_BAR; PG8_MMA(0, 0, At, B0); PG8_MMA(0, 1, At, B1); PG8_BAR; PG8_SCHED;
            PG8_LDA(At, 1, 1); PG8_STAGE(PG8_SB(1, 0), b3, voffB); PG8_STAGE(PG8_SB(1, 1), b3 + hstep, voffB); PG8_STAGE(PG8_SA(1, 0), a3, voffA);
            PG8_WAIT_V(8); PG8_WAIT_L(0); PG8_BAR; PG8_MMA(1, 0, At, B0); PG8_MMA(1, 1, At, B1); PG8_BAR; PG8_SCHED;
            } else {
            PG8_LDB(B0, 0, 0); PG8_SCHED; PG8_LDA(At, 0, 0); PG8_STAGE(PG8_SA(1, 1), a1 + hstep, voffA);
            PG8_WAIT_L(8); PG8_BAR; PG8_WAIT_L(0); PG8_MMA(0, 0, At, B0); PG8_BAR; PG8_SCHED;
            PG8_LDB(B1, 0, 1); PG8_STAGE(PG8_SB(0, 0), b2, voffB);
            PG8_BAR; PG8_WAIT_L(0); PG8_MMA(0, 1, At, B1); PG8_BAR;
            PG8_LDA(At, 0, 1); PG8_STAGE(PG8_SA(0, 0), a2, voffA);
            PG8_BAR; PG8_WAIT_L(0); PG8_MMA(1, 0, At, B0); PG8_BAR; PG8_SCHED;
            PG8_STAGE(PG8_SB(0, 1), b2 + hstep, voffB);
            PG8_WAIT_V(6); PG8_BAR; PG8_MMA(1, 1, At, B1); PG8_BAR;
            PG8_LDB(B0, 1, 0); PG8_SCHED; PG8_LDA(At, 1, 0); PG8_STAGE(PG8_SA(0, 1), a2 + hstep, voffA);
            PG8_WAIT_L(8); PG8_BAR; PG8_WAIT_L(0); PG8_MMA(0, 0, At, B0); PG8_BAR; PG8_SCHED;
            PG8_LDB(B1, 1, 1); PG8_STAGE(PG8_SB(1, 0), b3, voffB);
            PG8_BAR; PG8_WAIT_L(0); PG8_MMA(0, 1, At, B1); PG8_BAR;
            PG8_LDA(At, 1, 1); PG8_STAGE(PG8_SA(1, 0), a3, voffA);
            PG8_BAR; PG8_WAIT_L(0); PG8_MMA(1, 0, At, B0); PG8_BAR; PG8_SCHED;
            PG8_STAGE(PG8_SB(1, 1), b3 + hstep, voffB);
            PG8_WAIT_V(6); PG8_BAR; PG8_MMA(1, 1, At, B1); PG8_BAR;
            }
        }
        if constexpr (ALIGN_EPI) { if (wr == 0) PG8_BAR; }
        E(acc, cur, wr, wc, fr, fq);
        if (!has_next) break;
#pragma unroll
        for (int a = 0; a < 2; ++a)
#pragma unroll
            for (int b = 0; b < 2; ++b)
#pragma unroll
                for (int m = 0; m < 4; ++m)
#pragma unroll
                    for (int n = 0; n < 2; ++n) acc[a][b][m][n] = (f32x4){0.f, 0.f, 0.f, 0.f};
        cur = nxt; cA = nA; cB = nB; ++ui;
        if constexpr (ALIGN_EPI) { if (wr == 1) PG8_BAR; }
    }
    PG8_WAIT_V(0);
    if constexpr (!ALIGN_EPI) { if (wr == 0) PG8_BAR; }
    PG8_BAR;
#undef PG8_SA
#undef PG8_SB
#undef PG8_STAGE
#undef PG8_LDA
#undef PG8_LDB
#undef PG8_MMA
#undef PG8_WAIT_V
#undef PG8_WAIT_L
#undef PG8_BAR
#undef PG8_SCHED
}
}
using pg8::Unit;

struct SchedStd : pg8::TileOrder {
    const char* A; const char* B; size_t tstep;
    __device__ __forceinline__ const char* a_base(const Unit& u) const { return A + (size_t)u.pm * tstep; }
    __device__ __forceinline__ const char* b_base(const Unit& u) const { return B + (size_t)u.pn * tstep; }
};
struct SchedWin : pg8::TileOrder {
    const char* XN; const char* W; size_t tstep;
    __device__ __forceinline__ const char* a_base(const Unit& u) const { return u.pn < 4 ? XN + (size_t)u.pm * tstep : W + (size_t)u.pn * tstep; }
    __device__ __forceinline__ const char* b_base(const Unit& u) const { return u.pn < 4 ? W + (size_t)u.pn * tstep : XN + (size_t)u.pm * tstep; }
};

struct EpiWin {
    static constexpr bool PERM = true;
    bf16_t* prg; bf16_t* phy;
    __device__ __forceinline__ void operator()(const f32x4 (&acc)[2][2][4][2], const Unit& u, int wr, int wc, int fr, int fq) const {
        bf16_t* base; size_t ldc; int r0, c0;
        if (u.pn < 4) { base = prg; ldc = 1024; r0 = u.pm * 256; c0 = u.pn * 256; }
        else {
            r0 = (u.pn - 4) * 256; c0 = 0;
            if (u.pm < 32) { base = phy + (size_t)u.pm * 1536 * 256; ldc = 256; }
            else { const int b = (u.pm - 32) >> 4, t0 = ((u.pm - 32) & 15) * 256; base = phy + PHY_LAT_OFF + (size_t)b * 1536 * 4096 + t0; ldc = 4096; }
        }
        const int row0 = r0 + wr * 64 + fr, col0 = c0 + wc * 32 + 8 * fq;
#pragma unroll
        for (int ai = 0; ai < 2; ++ai)
#pragma unroll
            for (int m = 0; m < 4; ++m) { bf16_t* rowp = base + (size_t)(row0 + ai * 128 + m * 16) * ldc + col0;
#pragma unroll
                for (int bj = 0; bj < 2; ++bj) { const f32x4 v0 = acc[ai][bj][m][0], v1 = acc[ai][bj][m][1];
                    u32x4 w; w.x = pg8::cvt_pk_bf16(v0[0], v0[1]); w.y = pg8::cvt_pk_bf16(v0[2], v0[3]); w.z = pg8::cvt_pk_bf16(v1[0], v1[1]); w.w = pg8::cvt_pk_bf16(v1[2], v1[3]);
                    *(u32x4*)(rowp + bj * 128) = w; } }
    }
};
struct EpiUp {
    static constexpr bool PERM = true;
    bf16_t* A; bf16_t* Gb; int nt; int ldc;
    __device__ __forceinline__ void operator()(const f32x4 (&acc)[2][2][4][2], const Unit& u, int wr, int wc, int fr, int fq) const {
        bf16_t* base = u.pn < nt ? A : Gb; const int ct = u.pn < nt ? u.pn : u.pn - nt;
        const int row0 = u.pm * 256 + wr * 64 + fr, col0 = ct * 256 + wc * 32 + 8 * fq;
#pragma unroll
        for (int ai = 0; ai < 2; ++ai)
#pragma unroll
            for (int m = 0; m < 4; ++m) { bf16_t* rowp = base + (size_t)(row0 + ai * 128 + m * 16) * ldc + col0;
#pragma unroll
                for (int bj = 0; bj < 2; ++bj) { const f32x4 v0 = acc[ai][bj][m][0], v1 = acc[ai][bj][m][1];
                    u32x4 w; w.x = pg8::cvt_pk_bf16(v0[0], v0[1]); w.y = pg8::cvt_pk_bf16(v0[2], v0[3]); w.z = pg8::cvt_pk_bf16(v1[0], v1[1]); w.w = pg8::cvt_pk_bf16(v1[2], v1[3]);
                    *(u32x4*)(rowp + bj * 128) = w; } }
    }
};
template <bool F32SRC> struct EpiResT {
    static constexpr bool PERM = true;
    const float* xin_ctx; const float* xin_lat;
    const bf16_t* xin_b; bf16_t* out_b;
    const float* gate;
    bool dry;
    __device__ __forceinline__ void operator()(const f32x4 (&acc)[2][2][4][2], const Unit& u, int wr, int wc, int fr, int fq) const {
        if (dry) return;
        const int row0 = u.pm * 256 + wr * 64 + fr, col0 = u.pn * 256 + wc * 32 + 8 * fq;
        const float* gp = gate + (size_t)((u.pm < 32) ? 0 : 1 + ((u.pm - 32) >> 4)) * 6144 + col0;
        f32x4 gv[2][2];
#pragma unroll
        for (int bj = 0; bj < 2; ++bj)
#pragma unroll
            for (int n = 0; n < 2; ++n) gv[bj][n] = *(const f32x4*)(gp + bj * 128 + n * 4);
        if constexpr (F32SRC) {
            const float* xin = (u.pm < 32) ? xin_ctx : xin_lat;
#pragma unroll
            for (int ai = 0; ai < 2; ++ai)
#pragma unroll
                for (int mh = 0; mh < 2; ++mh) {
                    f32x4 xo[2][2][2];
#pragma unroll
                    for (int mm = 0; mm < 2; ++mm) { const size_t off = (size_t)(row0 + ai * 128 + (mh * 2 + mm) * 16) * 1024 + col0;
#pragma unroll
                        for (int bj = 0; bj < 2; ++bj)
#pragma unroll
                            for (int n = 0; n < 2; ++n) xo[mm][bj][n] = *(const f32x4*)(xin + off + bj * 128 + n * 4); }
#pragma unroll
                    for (int mm = 0; mm < 2; ++mm) { const size_t off = (size_t)(row0 + ai * 128 + (mh * 2 + mm) * 16) * 1024 + col0;
#pragma unroll
                        for (int bj = 0; bj < 2; ++bj) { const f32x4 v0 = xo[mm][bj][0] + gv[bj][0] * acc[ai][bj][mh * 2 + mm][0], v1 = xo[mm][bj][1] + gv[bj][1] * acc[ai][bj][mh * 2 + mm][1];
                            u32x4 w; w.x = pk2(v0[0], v0[1]); w.y = pk2(v0[2], v0[3]); w.z = pk2(v1[0], v1[1]); w.w = pk2(v1[2], v1[3]);
                            *(u32x4*)(out_b + off + bj * 128) = w; } }
                }
        } else {
#pragma unroll
            for (int ai = 0; ai < 2; ++ai) {
                u32x4 xo[4][2];
#pragma unroll
                for (int m = 0; m < 4; ++m) { const size_t off = (size_t)(row0 + ai * 128 + m * 16) * 1024 + col0;
#pragma unroll
                    for (int bj = 0; bj < 2; ++bj) xo[m][bj] = *(const u32x4*)(xin_b + off + bj * 128); }
#pragma unroll
                for (int m = 0; m < 4; ++m) { const size_t off = (size_t)(row0 + ai * 128 + m * 16) * 1024 + col0;
#pragma unroll
                    for (int bj = 0; bj < 2; ++bj) { const u32x4 x = xo[m][bj];
                        const f32x4 a0 = acc[ai][bj][m][0], a1 = acc[ai][bj][m][1], g0 = gv[bj][0], g1 = gv[bj][1];
                        u32x4 w;
                        w.x = pk2(bf2f(x.x & 0xffffu) + g0[0] * a0[0], bf2f(x.x >> 16) + g0[1] * a0[1]);
                        w.y = pk2(bf2f(x.y & 0xffffu) + g0[2] * a0[2], bf2f(x.y >> 16) + g0[3] * a0[3]);
                        w.z = pk2(bf2f(x.z & 0xffffu) + g1[0] * a1[0], bf2f(x.z >> 16) + g1[1] * a1[1]);
                        w.w = pk2(bf2f(x.w & 0xffffu) + g1[2] * a1[2], bf2f(x.w >> 16) + g1[3] * a1[3]);
                        *(u32x4*)(out_b + off + bj * 128) = w; } }
            }
        }
    }
};

__device__ __forceinline__ void phase_mod(CP& p, unsigned char* smem) {
    float* S = (float*)smem;
    float* red = (float*)(smem + 5 * 1024 * 4);
    const int tid = opaque_tid();
    if ((int)blockIdx.x >= 384) return;
    for (int i = tid; i < 5 * 1024; i += NTHR) { const int r = i >> 10, k = i & 1023; const float v = r == 0 ? p.in[I_CCTX][k] : p.in[I_C][(r - 1) * 1024 + k]; S[i] = v / (1.0f + __expf(-v)); }
    __syncthreads();
    float* MOD = (float*)(p.ws + WS_MOD);
    for (int it = blockIdx.x; it < 384; it += gridDim.x) {
        const int l = it / 192, cg_ = it % 192, q = tid & 7, rg = tid >> 3;
        const float* W = p.in[I_WADA] + (size_t)l * 1024 * 6144 + cg_ * 32 + q * 4;
        float acc[5][4];
#pragma unroll
        for (int r = 0; r < 5; ++r)
#pragma unroll
            for (int j = 0; j < 4; ++j) acc[r][j] = 0.f;
#pragma unroll 4
        for (int kk = 0; kk < 16; ++kk) { const int k = rg * 16 + kk; const f32x4 w = __builtin_nontemporal_load((const f32x4*)(W + (size_t)k * 6144));
#pragma unroll
            for (int r = 0; r < 5; ++r) { const float s = S[r * 1024 + k];
#pragma unroll
                for (int j = 0; j < 4; ++j) acc[r][j] += s * w[j]; } }
#pragma unroll
        for (int r = 0; r < 5; ++r)
#pragma unroll
            for (int j = 0; j < 4; ++j) red[(rg * 5 + r) * 32 + q * 4 + j] = acc[r][j];
        __syncthreads();
        if (tid < 160) { const int r = tid >> 5, cc = tid & 31; float s = 0.f;
            for (int g = 0; g < 64; ++g) s += red[(g * 5 + r) * 32 + cc];
            const int col = cg_ * 32 + cc;
            MOD[((size_t)l * 5 + r) * 6144 + col] = s + p.in[I_BADA][l * 6144 + col]; }
        __syncthreads();
    }
}

__device__ __forceinline__ void phase_h2(CP& p, unsigned char* smem) {
    { float* SP = (float*)(p.ws + WS_SP);
      for (int i = blockIdx.x * NTHR + threadIdx.x; i < 2 * 2 * 512; i += gridDim.x * NTHR) SP[i] = 8.0f * log1pf(expf(-p.in[I_RGA][i])); }
    { bf16_t* W3T = (bf16_t*)(p.ws + WS_W3T);
      for (int i = blockIdx.x * NTHR + threadIdx.x; i < 2 * 2048 * 64; i += gridDim.x * NTHR) { const int k = i & 63, col = (i >> 6) & 2047, ll = i >> 17;
          W3T[i] = (bf16_t)f2bf(p.in[I_HFW3][((size_t)ll * 64 + k) * 2048 + col]); } }
    float* F = (float*)smem;
    float* H1 = (float*)(smem + 8 * 33 * 4 + 32);
    const int tid = opaque_tid(), pi = tid >> 6, j = tid & 63;
    float* H2 = (float*)(p.ws + WS_H2);
    for (int it = blockIdx.x; it < 1088; it += gridDim.x) {
        const int Pg = it * 8 + pi, l = Pg / 4352, pp = Pg % 4352;
        const int path = pp < 256 ? 0 : 1, pos = path ? pp - 256 : pp, L = path ? 4096 : 256;
        if (j < 33) {
            const float t = (float)pos / (float)(L - 1);
            const float omega = 6.283185307179586f * (float)pos / (float)L;
            float f;
            if (j == 0) f = t;
            else { const int bi = (j - 1) & 15; const float band = 1e-4f + (float)bi * ((15.0f - 1e-4f) / 15.0f); const float ang = omega * band; f = j <= 16 ? cosf(ang) : sinf(ang); }
            F[pi * 33 + j] = f;
        }
        __syncthreads();
        {
            const float* w1 = p.in[I_HFW1] + (size_t)l * 33 * 64; float s = p.in[I_HFB1][l * 64 + j];
            for (int k = 0; k < 33; ++k) s += F[pi * 33 + k] * w1[k * 64 + j];
            H1[pi * 64 + j] = sinf(p.in[I_HFFR][l * 128 + j] * s);
        }
        __syncthreads();
        {
            const float* w2 = p.in[I_HFW2] + (size_t)l * 64 * 64; float s = p.in[I_HFB2][l * 64 + j];
            for (int k = 0; k < 64; ++k) s += H1[pi * 64 + k] * w2[k * 64 + j];
            const float hv = sinf(p.in[I_HFFR][l * 128 + 64 + j] * s);
            H2[((size_t)l * 4352 + pp) * 64 + j] = hv;
            ((bf16_t*)(p.ws + WS_H2B))[((size_t)l * 4352 + pp) * 64 + j] = (bf16_t)f2bf(hv);
        }
        __syncthreads();
    }
}

struct WTile { const float* src; bf16_t* dst; int N, k0s, n0s, ldk, kcol0; };
__device__ __forceinline__ WTile wtile_decode(CP& p, int l, int id) {
    WTile t; int kt, ntile;
    if (id < 640) { t.src = p.in[I_WIN] + (size_t)l * 1024 * 2560; t.N = 2560; kt = id / 40; ntile = id % 40; t.dst = (bf16_t*)(p.ws + WS_WIN) + (size_t)ntile * 64 * 1024; t.ldk = 1024; t.kcol0 = kt * 64; }
    else if (id < 896) { id -= 640; t.src = p.in[I_WOUT] + (size_t)l * 1024 * 1024; t.N = 1024; kt = id / 16; ntile = id % 16; t.dst = (bf16_t*)(p.ws + WS_WOUT) + (size_t)ntile * 64 * 1024; t.ldk = 1024; t.kcol0 = kt * 64; }
    else if (id < 2304) { t.src = p.in[I_WUP] + (size_t)l * 1024 * 5632; t.N = 5632;
        if (id < 1664) { id -= 896; const int nti = id >> 4; kt = id & 15; ntile = nti < 24 ? nti : 44 + (nti - 24); }
        else { id -= 1664; const int nti = id >> 4; kt = id & 15; ntile = nti < 20 ? 24 + nti : 68 + (nti - 20); }
        const int n0 = ntile * 64; int dr;
        if (n0 < 2816) dr = n0 < 1536 ? n0 : 3072 + (n0 - 1536); else { const int jn = n0 - 2816; dr = jn < 1536 ? 1536 + jn : 4352 + (jn - 1536); }
        t.dst = (bf16_t*)(p.ws + WS_WUP) + (size_t)dr * 1024; t.ldk = 1024; t.kcol0 = kt * 64; }
    else { id -= 2304; t.src = p.in[I_WDN] + (size_t)l * 2816 * 1024; t.N = 1024; kt = id >> 4; ntile = id & 15;
        const int k0 = kt * 64;
        if (k0 < 1536) { t.dst = (bf16_t*)(p.ws + WS_WDN0) + (size_t)ntile * 64 * 1536; t.ldk = 1536; t.kcol0 = k0; }
        else { t.dst = (bf16_t*)(p.ws + WS_WDN1) + (size_t)ntile * 64 * 1280; t.ldk = 1280; t.kcol0 = k0 - 1536; } }
    t.k0s = kt * 64; t.n0s = ntile * 64;
    return t;
}
__device__ __forceinline__ void phase_wconv(CP& p, int l, int lo, int hi, int first, int stride, bool do_gw, unsigned char* smem) {
    float* T = (float*)smem;
    const int tid = opaque_tid();
    for (int it = lo + first; it < hi; it += 2 * stride) {
        const bool two = it + stride < hi;
        const WTile ta = wtile_decode(p, l, it), tb = wtile_decode(p, l, two ? it + stride : it);
        const int kk = tid >> 4, n4 = (tid & 15) * 4;
        f32x4 va[2], vb[2];
#pragma unroll
        for (int h = 0; h < 2; ++h) { va[h] = __builtin_nontemporal_load((const f32x4*)(ta.src + (size_t)(ta.k0s + kk + h * 32) * ta.N + ta.n0s + n4));
            vb[h] = __builtin_nontemporal_load((const f32x4*)(tb.src + (size_t)(tb.k0s + kk + h * 32) * tb.N + tb.n0s + n4)); }
#pragma unroll
        for (int h = 0; h < 2; ++h) { float* tp = T + (kk + h * 32) * 65 + n4; tp[0] = va[h][0]; tp[1] = va[h][1]; tp[2] = va[h][2]; tp[3] = va[h][3];
            float* tq = T + 64 * 65 + (kk + h * 32) * 65 + n4; tq[0] = vb[h][0]; tq[1] = vb[h][1]; tq[2] = vb[h][2]; tq[3] = vb[h][3]; }
        __syncthreads();
        {
            const int nn = tid >> 3, k8 = (tid & 7) * 8; float v[8];
#pragma unroll
            for (int e = 0; e < 8; ++e) v[e] = T[(k8 + e) * 65 + nn];
            u32x4 w; w.x = pk2(v[0], v[1]); w.y = pk2(v[2], v[3]); w.z = pk2(v[4], v[5]); w.w = pk2(v[6], v[7]);
            *(u32x4*)(ta.dst + (size_t)nn * ta.ldk + ta.kcol0 + k8) = w;
            if (two) {
#pragma unroll
                for (int e = 0; e < 8; ++e) v[e] = T[64 * 65 + (k8 + e) * 65 + nn];
                w.x = pk2(v[0], v[1]); w.y = pk2(v[2], v[3]); w.z = pk2(v[4], v[5]); w.w = pk2(v[6], v[7]);
                *(u32x4*)(tb.dst + (size_t)nn * tb.ldk + tb.kcol0 + k8) = w;
            }
        }
        __syncthreads();
    }
    if (!do_gw) return;
    bf16_t* GW = (bf16_t*)(p.ws + WS_GW);
    const float* gsrc = p.in[I_RGGW] + (size_t)l * 65536 * 2;
    for (int i = blockIdx.x * NTHR + tid; i < 131072; i += gridDim.x * NTHR) {
        const int ii = i & 63, j = (i >> 6) & 63, dgh = i >> 12;
        GW[i] = (bf16_t)f2bf(gsrc[((size_t)dgh * 64 + ii) * 64 + j]);
    }
}

__device__ __forceinline__ void unpack8(const u32x4 r, float (&f)[8]) {
    f[0] = __uint_as_float(r.x << 16); f[1] = __uint_as_float(r.x & 0xffff0000u); f[2] = __uint_as_float(r.y << 16); f[3] = __uint_as_float(r.y & 0xffff0000u);
    f[4] = __uint_as_float(r.z << 16); f[5] = __uint_as_float(r.z & 0xffff0000u); f[6] = __uint_as_float(r.w << 16); f[7] = __uint_as_float(r.w & 0xffff0000u);
}
__device__ __forceinline__ void norm_emit(const float (&v)[4][2][8], int row, const float* mr, const float (&gg)[2][8], bf16_t* XN, int lane) {
    float sh[2][8], sc[2][8];
#pragma unroll
    for (int hh = 0; hh < 2; ++hh) { const f32x4 a = *(const f32x4*)(mr + hh * 512 + lane * 8), b = *(const f32x4*)(mr + hh * 512 + lane * 8 + 4);
        const f32x4 c = *(const f32x4*)(mr + 1024 + hh * 512 + lane * 8), d = *(const f32x4*)(mr + 1024 + hh * 512 + lane * 8 + 4);
#pragma unroll
        for (int e = 0; e < 4; ++e) { sh[hh][e] = a[e]; sh[hh][4 + e] = b[e]; sc[hh][e] = gg[hh][e] * (1.0f + c[e]); sc[hh][4 + e] = gg[hh][4 + e] * (1.0f + d[e]); } }
#pragma unroll
    for (int r = 0; r < 4; ++r) {
        float ss = 0.f;
#pragma unroll
        for (int hh = 0; hh < 2; ++hh)
#pragma unroll
            for (int e = 0; e < 8; ++e) ss += v[r][hh][e] * v[r][hh][e];
        ss = wave_sum(ss);
        const float rstd = rsqrtf(ss * (1.0f / 1024.0f) + EPS);
#pragma unroll
        for (int hh = 0; hh < 2; ++hh) { float o[8];
#pragma unroll
            for (int e = 0; e < 8; ++e) o[e] = (v[r][hh][e] * rstd) * sc[hh][e] + sh[hh][e];
            u32x4 w; w.x = pk2(o[0], o[1]); w.y = pk2(o[2], o[3]); w.z = pk2(o[4], o[5]); w.w = pk2(o[6], o[7]);
            *(u32x4*)(XN + (size_t)(row + r) * 1024 + hh * 512 + lane * 8) = w; }
    }
}
__device__ __forceinline__ void phase_norm(CP& p, int l, int which) {
    const int tid = opaque_tid(), wave = tid >> 6, lane = tid & 63;
    const float* g = p.in[which ? I_GN2 : I_GN1] + l * 1024;
    const float* MOD = (const float*)(p.ws + WS_MOD) + (size_t)l * 5 * 6144;
    bf16_t* XN = (bf16_t*)(p.ws + WS_XN);
    const bf16_t* XB = (const bf16_t*)p.out;
    const bool f32src = (l == 0 && which == 0);
    const int G = gridDim.x;
    float gg[2][8];
#pragma unroll
    for (int hh = 0; hh < 2; ++hh) { const f32x4 a = *(const f32x4*)(g + hh * 512 + lane * 8), b = *(const f32x4*)(g + hh * 512 + lane * 8 + 4);
        gg[hh][0] = a[0]; gg[hh][1] = a[1]; gg[hh][2] = a[2]; gg[hh][3] = a[3]; gg[hh][4] = b[0]; gg[hh][5] = b[1]; gg[hh][6] = b[2]; gg[hh][7] = b[3]; }
    if (f32src) {
        for (int rb = blockIdx.x; rb < MTOK / 32; rb += G) {
            const int row = rb * 32 + wave * 4;
            const float* mr = MOD + (size_t)mod_row(row) * 6144 + (which ? 3072 : 0);
            const float* x = row < NCTX ? p.in[I_XP] + (size_t)row * 1024 : p.in[I_XS] + (size_t)(row - NCTX) * 1024;
            f32x4 raw[4][2][2];
#pragma unroll
            for (int r = 0; r < 4; ++r)
#pragma unroll
                for (int hh = 0; hh < 2; ++hh) { raw[r][hh][0] = __builtin_nontemporal_load((const f32x4*)(x + r * 1024 + hh * 512 + lane * 8)); raw[r][hh][1] = __builtin_nontemporal_load((const f32x4*)(x + r * 1024 + hh * 512 + lane * 8 + 4)); }
            float v[4][2][8];
#pragma unroll
            for (int r = 0; r < 4; ++r)
#pragma unroll
                for (int hh = 0; hh < 2; ++hh)
#pragma unroll
                    for (int e = 0; e < 4; ++e) { v[r][hh][e] = raw[r][hh][0][e]; v[r][hh][4 + e] = raw[r][hh][1][e]; }
            norm_emit(v, row, mr, gg, XN, lane);
        }
    } else {
        int rb = blockIdx.x;
        u32x4 cur[4][2];
        if (rb < MTOK / 32) {
#pragma unroll
            for (int r = 0; r < 4; ++r)
#pragma unroll
                for (int hh = 0; hh < 2; ++hh) cur[r][hh] = __builtin_nontemporal_load((const u32x4*)(XB + (size_t)(rb * 32 + wave * 4 + r) * 1024 + hh * 512 + lane * 8));
        }
        for (; rb < MTOK / 32; rb += G) {
            const int row = rb * 32 + wave * 4, rbn = rb + G;
            const float* mr = MOD + (size_t)mod_row(row) * 6144 + (which ? 3072 : 0);
            u32x4 nxt[4][2];
            if (rbn < MTOK / 32) {
#pragma unroll
                for (int r = 0; r < 4; ++r)
#pragma unroll
                    for (int hh = 0; hh < 2; ++hh) nxt[r][hh] = __builtin_nontemporal_load((const u32x4*)(XB + (size_t)(rbn * 32 + wave * 4 + r) * 1024 + hh * 512 + lane * 8));
            }
            float v[4][2][8];
#pragma unroll
            for (int r = 0; r < 4; ++r)
#pragma unroll
                for (int hh = 0; hh < 2; ++hh) unpack8(cur[r][hh], v[r][hh]);
            norm_emit(v, row, mr, gg, XN, lane);
            if (rbn < MTOK / 32) {
#pragma unroll
                for (int r = 0; r < 4; ++r)
#pragma unroll
                    for (int hh = 0; hh < 2; ++hh) cur[r][hh] = nxt[r][hh];
            }
        }
    }
}
__device__ __forceinline__ void phase_final_norm(CP& p) {
    const int tid = opaque_tid(), wave = tid >> 6, lane = tid & 63;
    const float* g = p.in[I_GFIN];
    const bf16_t* XF = (const bf16_t*)(p.ws + WS_XN);
    float gg[2][8];
#pragma unroll
    for (int hh = 0; hh < 2; ++hh) { const f32x4 a = *(const f32x4*)(g + hh * 512 + lane * 8), b = *(const f32x4*)(g + hh * 512 + lane * 8 + 4);
        gg[hh][0] = a[0]; gg[hh][1] = a[1]; gg[hh][2] = a[2]; gg[hh][3] = a[3]; gg[hh][4] = b[0]; gg[hh][5] = b[1]; gg[hh][6] = b[2]; gg[hh][7] = b[3]; }
    for (int rb = blockIdx.x; rb < MTOK / 32; rb += gridDim.x) {
        const int row = rb * 32 + wave * 4;
        u32x4 raw[4][2];
#pragma unroll
        for (int r = 0; r < 4; ++r)
#pragma unroll
            for (int hh = 0; hh < 2; ++hh) raw[r][hh] = __builtin_nontemporal_load((const u32x4*)(XF + (size_t)(row + r) * 1024 + hh * 512 + lane * 8));
#pragma unroll
        for (int r = 0; r < 4; ++r) {
            float v[2][8]; float ss = 0.f;
#pragma unroll
            for (int hh = 0; hh < 2; ++hh) { unpack8(raw[r][hh], v[hh]);
#pragma unroll
                for (int e = 0; e < 8; ++e) ss += v[hh][e] * v[hh][e]; }
            ss = wave_sum(ss);
            const float rstd = rsqrtf(ss * (1.0f / 1024.0f) + EPS);
#pragma unroll
            for (int hh = 0; hh < 2; ++hh) { f32x4 o0, o1;
#pragma unroll
                for (int e = 0; e < 4; ++e) { o0[e] = (v[hh][e] * rstd) * gg[hh][e]; o1[e] = (v[hh][4 + e] * rstd) * gg[hh][4 + e]; }
                float* dst = p.out + (size_t)(row + r) * 1024 + hh * 512 + lane * 8;
                *(f32x4*)dst = o0; *(f32x4*)(dst + 4) = o1; }
        }
    }
}

__device__ __forceinline__ void phase_taps(CP& p, int l, unsigned char* smem) {
    const int tid = opaque_tid(), lane = tid & 63, wv = __builtin_amdgcn_readfirstlane(tid >> 6), fr = lane & 15, fq = lane >> 4;
    const bf16_t* H2b = (const bf16_t*)(p.ws + WS_H2B) + (size_t)l * 4352 * 64;
    const bf16_t* W3T = (const bf16_t*)(p.ws + WS_W3T) + (size_t)l * 2048 * 64;
    float* TAPS = (float*)(p.ws + WS_TAPS);
    for (int it = blockIdx.x; it < 544; it += gridDim.x) {
        const int ptile = it >> 3, cb = it & 7;
        const int path = ptile < 4 ? 0 : 1, pos0 = (path ? ptile - 4 : ptile) * 64, L = path ? 4096 : 256;
        const int pp0 = path ? 256 + pos0 : pos0, col0 = cb * 256 + wv * 32;
        bf16x8 a[4][2], b[2][2];
#pragma unroll
        for (int pt = 0; pt < 4; ++pt)
#pragma unroll
            for (int kk = 0; kk < 2; ++kk) a[pt][kk] = *(const bf16x8*)(H2b + (size_t)(pp0 + pt * 16 + fr) * 64 + kk * 32 + fq * 8);
#pragma unroll
        for (int ct = 0; ct < 2; ++ct)
#pragma unroll
            for (int kk = 0; kk < 2; ++kk) b[ct][kk] = *(const bf16x8*)(W3T + (size_t)(col0 + ct * 16 + fr) * 64 + kk * 32 + fq * 8);
        float* outb = TAPS + (path ? TAPS_LAT_OFF : 0);
        const float invL = 1.0f / (float)(L - 1);
#pragma unroll
        for (int ct = 0; ct < 2; ++ct) {
            const int col = col0 + ct * 16 + fr, c = col & 511;
            const float delta = fabsf(-3.0701134573253945f + (float)c * ((-15.350567286626972f + 3.0701134573253945f) / 511.0f));
#pragma unroll
            for (int pt = 0; pt < 4; ++pt) {
                f32x4 acc = (f32x4){0.f, 0.f, 0.f, 0.f};
#pragma unroll
                for (int kk = 0; kk < 2; ++kk) acc = __builtin_amdgcn_mfma_f32_16x16x32_bf16(a[pt][kk], b[ct][kk], acc, 0, 0, 0);
                const int pos = pos0 + pt * 16 + fq * 4;
                f32x4 o;
#pragma unroll
                for (int jj = 0; jj < 4; ++jj) o[jj] = acc[jj] * __expf(-((float)(pos + jj) * invL) * delta);
                *(f32x4*)(outb + (size_t)col * L + pos) = o;
            }
        }
    }
}

constexpr int RG_XR = 0, RG_YR = 35840, RG_OR = 68608, RG_XCB = 101376;
template <bool REV, bool WANT_H>
__device__ __forceinline__ void rg_scan_tile(const float (&a)[4], float (&b)[4], float hc, int lane, float& AT, float& BT) {
    const int q = lane >> 4, pos = REV ? 3 - q : q;
    float IA = 1.f, IB = 0.f;
#pragma unroll
    for (int jj = 0; jj < 4; ++jj) { const int j = REV ? 3 - jj : jj; IB = a[j] * IB + b[j]; IA *= a[j]; }
    {
        const int src = (REV ? lane + 16 : lane - 16) & 63;
        const float pA = __shfl(IA, src), pB = __shfl(IB, src);
        if (pos >= 1) { IB = IA * pB + IB; IA = pA * IA; }
    }
    {
        const int src = (REV ? lane + 32 : lane - 32) & 63;
        const float pA = __shfl(IA, src), pB = __shfl(IB, src);
        if (pos >= 2) { IB = IA * pB + IB; IA = pA * IA; }
    }
    const int last = (REV ? 0 : 48) + (lane & 15);
    AT = __shfl(IA, last); BT = __shfl(IB, last);
    if (WANT_H) {
        const int src = (REV ? lane + 16 : lane - 16) & 63;
        float EA = __shfl(IA, src), EB = __shfl(IB, src);
        if (pos == 0) { EA = 1.f; EB = 0.f; }
        float h = EA * hc + EB;
#pragma unroll
        for (int jj = 0; jj < 4; ++jj) { const int j = REV ? 3 - jj : jj; h = a[j] * h + b[j]; b[j] = h; }
    }
}
template <int PASS>
__device__ __forceinline__ void rg_item(CP& p, int l, int ci, unsigned char* smem) {
    const int tid = opaque_tid(), lane = tid & 63, wave = __builtin_amdgcn_readfirstlane(tid >> 6), fr = lane & 15, fq = lane >> 4;
    bf16_t* XR = (bf16_t*)(smem + RG_XR);
    bf16_t* YR = (bf16_t*)(smem + RG_YR);
    bf16_t* OR = (bf16_t*)(smem + RG_OR);
    bf16_t* XCb = (bf16_t*)(smem + RG_XCB) + wave * (32 * 72);
    const bf16_t* PRG = (const bf16_t*)(p.ws + WS_PRG);
    float2* AGG = (float2*)(p.ws + WS_AGG);
    const bf16_t* GW = (const bf16_t*)(p.ws + WS_GW);
    const float* SPt = (const float*)(p.ws + WS_SP) + l * 1024;
    const float* GBt = p.in[I_RGGB] + l * 2048;
    int s, k, nch, L, cibase;
    if (ci < 256) { s = ci >> 3; k = ci & 7; nch = 8; L = 256; cibase = ci - k; }
    else { const int cl = ci - 256; s = 32 + (cl >> 7); k = cl & 127; nch = 128; L = 4096; cibase = ci - k; }
    const int r0 = ci * 32, t0 = k * 32;
    const int h = wave, chl = h * 64 + lane;
    {
        u32x4 vals[5], yv[4];
#pragma unroll
        for (int i = 0; i < 5; ++i) { const int v = tid + i * NTHR, rr = v >> 6, cv = v & 63; const int t = t0 - 2 + rr;
            vals[i] = (u32x4){0u, 0u, 0u, 0u};
            if (rr < 35 && t >= 0 && t < L) vals[i] = (PASS == 3) ? __builtin_nontemporal_load((const u32x4*)(PRG + (size_t)(r0 - 2 + rr) * 1024 + cv * 8)) : *(const u32x4*)(PRG + (size_t)(r0 - 2 + rr) * 1024 + cv * 8); }
        if (PASS == 3) {
#pragma unroll
            for (int i = 0; i < 4; ++i) { const int v = tid + i * NTHR, rr = v >> 6, cv = v & 63; yv[i] = __builtin_nontemporal_load((const u32x4*)(PRG + (size_t)(r0 + rr) * 1024 + 512 + cv * 8)); }
        }
#pragma unroll
        for (int i = 0; i < 5; ++i) { const int v = tid + i * NTHR, rr = v >> 6, cv = v & 63;
            if (rr < 35) *(u32x4*)(XR + rr * 512 + cv * 8) = vals[i]; }
        if (PASS == 3) {
#pragma unroll
            for (int i = 0; i < 4; ++i) { const int v = tid + i * NTHR, rr = v >> 6, cv = v & 63; *(u32x4*)(YR + rr * 512 + cv * 8) = yv[i]; }
        }
    }
    float cf = 0.f, cbk = 0.f;
    if (PASS == 3) {
        if (s >= 32) { const float* st = p.in[I_ST] + ((size_t)((s - 32) * 2 + l) * 2) * 512; cf = st[chl]; cbk = st[512 + chl]; }
#pragma unroll 32
        for (int j = 0; j < k; ++j) { const float2 ab = AGG[((size_t)(cibase + j) * 2 + 0) * 512 + chl]; cf = ab.x * cf + ab.y; }
#pragma unroll 32
        for (int j = nch - 1; j > k; --j) { const float2 ab = AGG[((size_t)(cibase + j) * 2 + 1) * 512 + chl]; cbk = ab.x * cbk + ab.y; }
    }
    const float* cwp = p.in[I_RGCW] + (size_t)l * 4 * 512;
    const float w0 = cwp[chl], w1 = cwp[512 + chl], w2 = cwp[1024 + chl], w3 = cwp[1536 + chl], wb = p.in[I_RGCB][l * 512 + chl];
    __syncthreads();
    {
        float x0 = bf2f(XR[0 * 512 + chl]), x1 = bf2f(XR[1 * 512 + chl]), x2 = bf2f(XR[2 * 512 + chl]);
#pragma unroll
        for (int t = 0; t < 32; ++t) { const float x3 = bf2f(XR[(t + 3) * 512 + chl]);
            XCb[t * 72 + lane] = (bf16_t)f2bf(wb + w0 * x0 + w1 * x1 + w2 * x2 + w3 * x3); x0 = x1; x1 = x2; x2 = x3; }
    }
    asm volatile("s_waitcnt lgkmcnt(0)" ::: "memory");
    bf16x8 afr[2][2];
#pragma unroll
    for (int tb = 0; tb < 2; ++tb)
#pragma unroll
        for (int kk = 0; kk < 2; ++kk) afr[tb][kk] = *(const bf16x8*)(XCb + (tb * 16 + fr) * 72 + kk * 32 + fq * 8);
    float* ns = p.out + (size_t)MTOK * 1024 + ((size_t)((s & 31) * 2 + l) * 2) * 512;
    bf16x8 bcur[2][2][2]; float ccur[2][3];
#pragma unroll
    for (int d = 0; d < 2; ++d) {
#pragma unroll
        for (int g = 0; g < 2; ++g)
#pragma unroll
            for (int kk = 0; kk < 2; ++kk) bcur[d][g][kk] = *(const bf16x8*)(GW + ((size_t)(((d * 2 + g) * 8 + h) * 64 + fr)) * 64 + kk * 32 + fq * 8);
        ccur[d][0] = GBt[(d * 2 + 0) * 512 + h * 64 + fr]; ccur[d][1] = GBt[(d * 2 + 1) * 512 + h * 64 + fr]; ccur[d][2] = SPt[d * 512 + h * 64 + fr];
    }
#pragma unroll 2
    for (int cb = 0; cb < 4; ++cb) {
        const int cl = cb * 16 + fr, c = h * 64 + cl, srcl = cb * 16 + fr;
        bf16x8 bnxt[2][2][2]; float cnxt[2][3];
        if (cb < 3) {
            const int cn = cl + 16;
#pragma unroll
            for (int d = 0; d < 2; ++d) {
#pragma unroll
                for (int g = 0; g < 2; ++g)
#pragma unroll
                    for (int kk = 0; kk < 2; ++kk) bnxt[d][g][kk] = *(const bf16x8*)(GW + ((size_t)(((d * 2 + g) * 8 + h) * 64 + cn)) * 64 + kk * 32 + fq * 8);
                cnxt[d][0] = GBt[(d * 2 + 0) * 512 + h * 64 + cn]; cnxt[d][1] = GBt[(d * 2 + 1) * 512 + h * 64 + cn]; cnxt[d][2] = SPt[d * 512 + h * 64 + cn];
            }
        }
        const float v0 = __shfl(w0, srcl), v1 = __shfl(w1, srcl), v2 = __shfl(w2, srcl), v3 = __shfl(w3, srcl), vb = __shfl(wb, srcl);
        const float hcf = __shfl(cf, srcl), hcb = __shfl(cbk, srcl);
        f32x4 acc[2][2][2];
#pragma unroll
        for (int tb = 0; tb < 2; ++tb)
#pragma unroll
            for (int d = 0; d < 2; ++d)
#pragma unroll
                for (int g = 0; g < 2; ++g) acc[tb][d][g] = (f32x4){0.f, 0.f, 0.f, 0.f};
#pragma unroll
        for (int d = 0; d < 2; ++d)
#pragma unroll
            for (int g = 0; g < 2; ++g)
#pragma unroll
                for (int kk = 0; kk < 2; ++kk) {
#pragma unroll
                    for (int tb = 0; tb < 2; ++tb) acc[tb][d][g] = __builtin_amdgcn_mfma_f32_16x16x32_bf16(afr[tb][kk], bcur[d][g][kk], acc[tb][d][g], 0, 0, 0);
                }
        float xc[2][4];
#pragma unroll
        for (int tb = 0; tb < 2; ++tb) { float xr[7];
#pragma unroll
            for (int i = 0; i < 7; ++i) xr[i] = bf2f(XR[(tb * 16 + fq * 4 + i) * 512 + c]);
#pragma unroll
            for (int j = 0; j < 4; ++j) xc[tb][j] = vb + v0 * xr[j] + v1 * xr[j + 1] + v2 * xr[j + 2] + v3 * xr[j + 3]; }
        float hs[2][4];
#pragma unroll
        for (int d = 0; d < 2; ++d) {
            const float br = ccur[d][0], bi = ccur[d][1], sp = ccur[d][2];
            float a[2][4], b[2][4];
#pragma unroll
            for (int tb = 0; tb < 2; ++tb)
#pragma unroll
                for (int j = 0; j < 4; ++j) {
                    const float e1 = __expf(-(acc[tb][d][0][j] + br)), e2 = __expf(-(acc[tb][d][1][j] + bi));
                    const float p1 = 1.0f + e1, p2 = 1.0f + e2, inv = __builtin_amdgcn_rcpf(p1 * p2);
                    const float r = p2 * inv, ig = p1 * inv;
                    const float la = -sp * r, av = __expf(la);
                    const float om = 1.0f - av * av;
                    a[tb][j] = av; b[tb][j] = xc[tb][j] * ig * __builtin_amdgcn_sqrtf(fmaxf(om, 0.f)); }
            float A0, B0, A1, B1;
            if (d == 0) {
                rg_scan_tile<false, PASS == 3>(a[0], b[0], hcf, lane, A0, B0);
                const float hmid = A0 * hcf + B0;
                rg_scan_tile<false, PASS == 3>(a[1], b[1], hmid, lane, A1, B1);
                if (PASS == 1) { if (fq == 0) AGG[((size_t)ci * 2 + 0) * 512 + c] = make_float2(A0 * A1, A1 * B0 + B1); }
                else if (s < 32 && k == nch - 1 && fq == 3) ns[c] = b[1][3];
            } else {
                rg_scan_tile<true, PASS == 3>(a[1], b[1], hcb, lane, A1, B1);
                const float hmid = A1 * hcb + B1;
                rg_scan_tile<true, PASS == 3>(a[0], b[0], hmid, lane, A0, B0);
                if (PASS == 1) { if (fq == 0) AGG[((size_t)ci * 2 + 1) * 512 + c] = make_float2(A1 * A0, A0 * B1 + B0); }
                else if (s < 32 && k == 0 && fq == 0) ns[512 + c] = b[0][0];
            }
            if (PASS == 3) {
#pragma unroll
                for (int tb = 0; tb < 2; ++tb)
#pragma unroll
                    for (int j = 0; j < 4; ++j) hs[tb][j] = d == 0 ? b[tb][j] : hs[tb][j] + b[tb][j];
            }
        }
        if (PASS == 3) {
#pragma unroll
            for (int tb = 0; tb < 2; ++tb)
#pragma unroll
                for (int j = 0; j < 4; ++j) { const int t = tb * 16 + fq * 4 + j;
                    OR[t * 512 + c] = (bf16_t)f2bf(hs[tb][j] * gelu_fast(bf2f(YR[t * 512 + c]))); }
        }
        if (cb < 3) {
#pragma unroll
            for (int d = 0; d < 2; ++d) {
#pragma unroll
                for (int g = 0; g < 2; ++g)
#pragma unroll
                    for (int kk = 0; kk < 2; ++kk) bcur[d][g][kk] = bnxt[d][g][kk];
                ccur[d][0] = cnxt[d][0]; ccur[d][1] = cnxt[d][1]; ccur[d][2] = cnxt[d][2];
            }
        }
    }
    __syncthreads();
    if (PASS == 3) {
        bf16_t* O = (bf16_t*)(p.ws + WS_XN);
        const float* gr = p.in[I_GRNN] + l * 512;
#pragma unroll 1
        for (int q = 0; q < 4; ++q) { const int t = wave * 4 + q;
            const u32x4 v = *(const u32x4*)(OR + t * 512 + lane * 8);
            float f[8] = { bf2f(v.x & 0xffffu), bf2f(v.x >> 16), bf2f(v.y & 0xffffu), bf2f(v.y >> 16), bf2f(v.z & 0xffffu), bf2f(v.z >> 16), bf2f(v.w & 0xffffu), bf2f(v.w >> 16) };
            float ss = 0.f;
#pragma unroll
            for (int e = 0; e < 8; ++e) ss += f[e] * f[e];
            ss = wave_sum(ss);
            const float rstd = rsqrtf(ss * (1.0f / 512.0f) + EPS);
            const f32x4 g0 = *(const f32x4*)(gr + lane * 8), g1 = *(const f32x4*)(gr + lane * 8 + 4);
            u32x4 w; w.x = pk2(f[0] * rstd * g0[0], f[1] * rstd * g0[1]); w.y = pk2(f[2] * rstd * g0[2], f[3] * rstd * g0[3]);
            w.z = pk2(f[4] * rstd * g1[0], f[5] * rstd * g1[1]); w.w = pk2(f[6] * rstd * g1[2], f[7] * rstd * g1[3]);
            *(u32x4*)(O + (size_t)(r0 + t) * 1024 + lane * 8) = w; }
        __syncthreads();
    }
}

#ifndef HD
#define HD __host__ __device__ __forceinline__
#endif
HD int PADX(int i) { return i + (i >> 4); }
constexpr int FFT_N = 8192;
constexpr int FFT_BUF_BYTES = (FFT_N + FFT_N / 16) * 8;
template <int R> struct Log2 { static constexpr int v = 1 + Log2<R / 2>::v; };
template <> struct Log2<1> { static constexpr int v = 0; };
template <int R> HD int bitrev_c(int x) { int r = 0;
#pragma unroll
    for (int i = 0; i < Log2<R>::v; ++i) if (x & (1 << i)) r |= (R >> (i + 1));
    return r; }
HD void twid_unit(int num, int den, float& c, float& s) {
    const float rev = (float)num / (float)den;
#if defined(__HIP_DEVICE_COMPILE__)
    c = __builtin_amdgcn_cosf(rev); s = -__builtin_amdgcn_sinf(rev);
#else
    c = (float)cos(6.283185307179586 * (double)rev); s = -(float)sin(6.283185307179586 * (double)rev);
#endif
}
template <int R> HD void fft_reg(v2f (&v)[R]) {
#pragma unroll
    for (int st = 0; st < Log2<R>::v; ++st) {
        const int half = (R / 2) >> st;
#pragma unroll
        for (int i = 0; i < R; ++i) {
            if ((i & half) == 0) {
                const v2f a = v[i], b = v[i + half];
                v[i] = a + b;
                const v2f d = a - b;
                const int tw = (i & (half - 1)) * (R / (2 * half));
                const v2f ds = __builtin_shufflevector(d, d, 1, 0);
                if (tw == 0) v[i + half] = d;
                else if (tw * 4 == R) v[i + half] = ds * (v2f){1.0f, -1.0f};
                else {
                    const float c = (float)__builtin_cos(6.283185307179586 * (double)tw / (double)R), sn = (float)__builtin_sin(6.283185307179586 * (double)tw / (double)R);
                    v[i + half] = d * (v2f){c, c} + ds * (v2f){sn, -sn};
                }
            }
        }
    }
}
template <int R, int NS> HD void fft_step_load(const float2* buf, int j, v2f (&v)[R]) {
    const v2f* bp = (const v2f*)buf + PADX(j);
#pragma unroll
    for (int r = 0; r < R; ++r) v[r] = bp[r * (FFT_N / R + FFT_N / R / 16)];
    if (NS > 1) {
        const int k = j & (NS - 1);
        float c1, s1; twid_unit(k, NS * R, c1, s1);
        v2f w = (v2f){c1, s1};
        const v2f w1c = (v2f){c1, c1}, w1s = (v2f){-s1, s1};
#pragma unroll
        for (int r = 1; r < R; ++r) {
            const v2f x = v[r], xs = __builtin_shufflevector(x, x, 1, 0);
            const v2f wsn = __builtin_shufflevector(w, w, 1, 1) * (v2f){-1.0f, 1.0f};
            v[r] = x * __builtin_shufflevector(w, w, 0, 0) + xs * wsn;
            w = w * w1c + __builtin_shufflevector(w, w, 1, 0) * w1s;
        }
    }
    fft_reg<R>(v);
}
template <int R, int NS> HD void fft_step_store(float2* buf, int j, const v2f (&v)[R]) {
    const int k = j & (NS - 1);
    const int idxD = (j - k) * R + k;
    v2f* bp = (v2f*)buf + PADX(idxD);
#pragma unroll
    for (int q = 0; q < R; ++q) { const int qq = bitrev_c<R>(q); bp[NS >= 16 ? qq * (NS + NS / 16) : PADX(qq * NS)] = v[q]; }
}
__device__ __forceinline__ void fft8192(float2* buf, int tid) {
    __syncthreads();
    {
        v2f v[32];
        if (tid < 256) fft_step_load<32, 1>(buf, tid, v);
        __syncthreads();
        if (tid < 256) fft_step_store<32, 1>(buf, tid, v);
        __syncthreads();
    }
    {
        v2f v[16];
        int j = tid; asm volatile("" : "+v"(j));
        fft_step_load<16, 32>(buf, j, v);
        __syncthreads();
        fft_step_store<16, 32>(buf, j, v);
        __syncthreads();
    }
    {
        v2f v[16];
        int j = tid; asm volatile("" : "+v"(j));
        fft_step_load<16, 512>(buf, j, v);
        __syncthreads();
        fft_step_store<16, 512>(buf, j, v);
        __syncthreads();
    }
}
template <int ORD> HD void spec_mul(float2* X, const float2* KF, int tid) {
    const int pb = PADX(tid), mb = PADX(FFT_N - tid);
#pragma unroll 2
    for (int j = 0; j < 16; ++j) {
        const int pn = pb + 544 * j, pm = (tid == 0 && j == 0) ? 0 : mb - 544 * j;
        const float2 x = X[pn], zk = KF[pn], zm = KF[pm];
        float kr, ki;
        if (ORD == 0) { kr = 0.5f * (zk.x + zm.x); ki = 0.5f * (zk.y - zm.y); }
        else { kr = 0.5f * (zk.y + zm.y); ki = -0.5f * (zk.x - zm.x); }
        const float yr = x.x * kr - x.y * ki, yi = x.x * ki + x.y * kr;
        X[pn] = make_float2(yr * (1.0f / FFT_N), -yi * (1.0f / FFT_N));
    }
}

struct HyW { float wv0, wv1, wv2, bv, wa0, wa1, wa2, ba, wb0, wb1, wb2, bb, bias0, bias1; };
__device__ __forceinline__ void hyconv16(const bf16_t* row, int t0, int L, float w0, float w1, float w2, float b, float (&o)[16]) {
    const u32x4 a = *(const u32x4*)(row + t0), c = *(const u32x4*)(row + t0 + 8);
    float x[18];
    x[0] = t0 > 0 ? bf2f(row[t0 - 1]) : 0.f;
    x[17] = t0 + 16 < L ? bf2f(row[t0 + 16]) : 0.f;
    x[1] = bf2f(a.x & 0xffffu); x[2] = bf2f(a.x >> 16); x[3] = bf2f(a.y & 0xffffu); x[4] = bf2f(a.y >> 16);
    x[5] = bf2f(a.z & 0xffffu); x[6] = bf2f(a.z >> 16); x[7] = bf2f(a.w & 0xffffu); x[8] = bf2f(a.w >> 16);
    x[9] = bf2f(c.x & 0xffffu); x[10] = bf2f(c.x >> 16); x[11] = bf2f(c.y & 0xffffu); x[12] = bf2f(c.y >> 16);
    x[13] = bf2f(c.z & 0xffffu); x[14] = bf2f(c.z >> 16); x[15] = bf2f(c.w & 0xffffu); x[16] = bf2f(c.w >> 16);
#pragma unroll
    for (int e = 0; e < 16; ++e) o[e] = b + w0 * x[e] + w1 * x[e + 1] + w2 * x[e + 2];
}
template <int PATH>
__device__ __forceinline__ void hy_group(float2* X, const float2* KF, bf16_t* vbase, const HyW& w, int tid, bool dry) {
    constexpr int L = PATH ? 4096 : 256;
    constexpr size_t SSTR = (size_t)1536 * L;
    constexpr size_t CH = (size_t)512 * L;
    const bool act = PATH ? (tid < 256) : ((tid & 31) < 16);
    const int t0 = PATH ? tid * 16 : (tid & 31) * 16;
    bf16_t* r0p = PATH ? vbase : vbase + (size_t)(tid >> 5) * 2 * SSTR;
    float2* xs = X + tid * 17;
    float2 sv[16];
    {
        float o0[16], o1[16];
        if (act) { hyconv16(r0p, t0, L, w.wv0, w.wv1, w.wv2, w.bv, o0); hyconv16(r0p + SSTR, t0, L, w.wv0, w.wv1, w.wv2, w.bv, o1); }
#pragma unroll
        for (int e = 0; e < 16; ++e) { sv[e] = act ? make_float2(o0[e], o1[e]) : make_float2(0.f, 0.f); xs[e] = sv[e]; }
    }
    fft8192(X, tid); spec_mul<0>(X, KF, tid); fft8192(X, tid);
    {
        float o0[16], o1[16];
        if (act) { hyconv16(r0p + CH, t0, L, w.wa0, w.wa1, w.wa2, w.ba, o0); hyconv16(r0p + CH + SSTR, t0, L, w.wa0, w.wa1, w.wa2, w.ba, o1); }
#pragma unroll
        for (int e = 0; e < 16; ++e) { const float2 r = xs[e];
            sv[e] = act ? make_float2(o0[e] * (r.x + w.bias0 * sv[e].x), o1[e] * (-r.y + w.bias0 * sv[e].y)) : make_float2(0.f, 0.f); }
        __syncthreads();
#pragma unroll
        for (int e = 0; e < 16; ++e) xs[e] = sv[e];
    }
    fft8192(X, tid); spec_mul<1>(X, KF, tid); fft8192(X, tid);
    if (act) {
        float o0[16], o1[16];
        hyconv16(r0p + 2 * CH, t0, L, w.wb0, w.wb1, w.wb2, w.bb, o0); hyconv16(r0p + 2 * CH + SSTR, t0, L, w.wb0, w.wb1, w.wb2, w.bb, o1);
        float y0[16], y1[16];
#pragma unroll
        for (int e = 0; e < 16; ++e) { const float2 r = xs[e]; y0[e] = o0[e] * (r.x + w.bias1 * sv[e].x); y1[e] = o1[e] * (-r.y + w.bias1 * sv[e].y); }
        u32x4 p0, p1, q0, q1;
        p0.x = pk2(y0[0], y0[1]); p0.y = pk2(y0[2], y0[3]); p0.z = pk2(y0[4], y0[5]); p0.w = pk2(y0[6], y0[7]);
        p1.x = pk2(y0[8], y0[9]); p1.y = pk2(y0[10], y0[11]); p1.z = pk2(y0[12], y0[13]); p1.w = pk2(y0[14], y0[15]);
        q0.x = pk2(y1[0], y1[1]); q0.y = pk2(y1[2], y1[3]); q0.z = pk2(y1[4], y1[5]); q0.w = pk2(y1[6], y1[7]);
        q1.x = pk2(y1[8], y1[9]); q1.y = pk2(y1[10], y1[11]); q1.z = pk2(y1[12], y1[13]); q1.w = pk2(y1[14], y1[15]);
        if (!dry) { *(u32x4*)(r0p + t0) = p0; *(u32x4*)(r0p + t0 + 8) = p1; *(u32x4*)(r0p + SSTR + t0) = q0; *(u32x4*)(r0p + SSTR + t0 + 8) = q1; }
    }
}
template <int PATH>
__device__ __forceinline__ void hy_filter(float2* KF, const float* T, int c, int tid, int pb) {
    constexpr int L = PATH ? 4096 : 256;
    const float* f0 = T + (size_t)(0 * 1024 + c) * L; const float* b0 = T + (size_t)(0 * 1024 + 512 + c) * L;
    const float* f1 = T + (size_t)(1 * 1024 + c) * L; const float* b1 = T + (size_t)(1 * 1024 + 512 + c) * L;
    __syncthreads();
    for (int j = 0; j < 16; ++j) { const int n = tid + 512 * j; float re = 0.f, im = 0.f;
        if (n < L) { re = f0[n]; im = f1[n]; }
        else if (n > FFT_N - L) { const int jj = FFT_N - n; re = b0[jj]; im = b1[jj]; }
        KF[pb + 544 * j] = make_float2(re, im); }
    fft8192(KF, tid);
}
__device__ __forceinline__ void hyena_item(CP& p, int l, int c, unsigned char* smem, bool dry) {
    float2* X = (float2*)smem; float2* KF = (float2*)(smem + FFT_BUF_BYTES);
    const int tid = opaque_tid(), pb = PADX(tid);
    bf16_t* PHY = (bf16_t*)(p.ws + WS_PHY);
    const float* TAPS = (const float*)(p.ws + WS_TAPS);
    const float* cw = p.in[I_HYCW] + (size_t)l * 3 * 1536; const float* cb = p.in[I_HYCB] + l * 1536;
    HyW w;
    w.wv0 = cw[c]; w.wv1 = cw[1536 + c]; w.wv2 = cw[3072 + c]; w.bv = cb[c];
    w.wa0 = cw[512 + c]; w.wa1 = cw[1536 + 512 + c]; w.wa2 = cw[3072 + 512 + c]; w.ba = cb[512 + c];
    w.wb0 = cw[1024 + c]; w.wb1 = cw[1536 + 1024 + c]; w.wb2 = cw[3072 + 1024 + c]; w.bb = cb[1024 + c];
    w.bias0 = p.in[I_HYB][(l * 2 + 0) * 512 + c]; w.bias1 = p.in[I_HYB][(l * 2 + 1) * 512 + c];
    hy_filter<0>(KF, TAPS, c, tid, pb);
    hy_group<0>(X, KF, PHY + (size_t)c * 256, w, tid, dry);
    hy_filter<1>(KF, TAPS + TAPS_LAT_OFF, c, tid, pb);
#pragma unroll 1
    for (int g = 0; g < 2; ++g) hy_group<1>(X, KF, PHY + PHY_LAT_OFF + ((size_t)(2 * g) * 1536 + c) * 4096, w, tid, dry);
}
__device__ __forceinline__ void hytrans_item(CP& p, int l, int rt, unsigned char* smem) {
    bf16_t* Tl = (bf16_t*)smem;
    const int tid = opaque_tid(), lane = tid & 63, wave = tid >> 6;
    const bf16_t* PHY = (const bf16_t*)(p.ws + WS_PHY);
    const bf16_t* base; size_t ldc;
    if (rt < 128) { base = PHY + ((size_t)(rt >> 2) * 1536) * 256 + (rt & 3) * 64; ldc = 256; }
    else { const int rl = rt - 128; base = PHY + PHY_LAT_OFF + ((size_t)(rl >> 6) * 1536) * 4096 + (rl & 63) * 64; ldc = 4096; }
    for (int v = tid; v < 512 * 8; v += NTHR) { const int c = v >> 3, q = v & 7;
        const u32x4 d = __builtin_nontemporal_load((const u32x4*)(base + (size_t)c * ldc + q * 8));
        unsigned* dst = (unsigned*)(Tl + c * 66 + q * 8); dst[0] = d.x; dst[1] = d.y; dst[2] = d.z; dst[3] = d.w; }
    __syncthreads();
    bf16_t* O = (bf16_t*)(p.ws + WS_XN);
    const float* gh = p.in[I_GHY] + l * 512;
    const f32x4 g0 = *(const f32x4*)(gh + lane * 8), g1 = *(const f32x4*)(gh + lane * 8 + 4);
#pragma unroll 1
    for (int q = 0; q < 8; ++q) { const int t = wave * 8 + q;
        float f[8]; float ss = 0.f;
#pragma unroll
        for (int e = 0; e < 8; ++e) { f[e] = bf2f(Tl[(lane * 8 + e) * 66 + t]); ss += f[e] * f[e]; }
        ss = wave_sum(ss);
        const float rstd = rsqrtf(ss * (1.0f / 512.0f) + EPS);
        u32x4 w; w.x = pk2(f[0] * rstd * g0[0], f[1] * rstd * g0[1]); w.y = pk2(f[2] * rstd * g0[2], f[3] * rstd * g0[3]);
        w.z = pk2(f[4] * rstd * g1[0], f[5] * rstd * g1[1]); w.w = pk2(f[6] * rstd * g1[2], f[7] * rstd * g1[3]);
        *(u32x4*)(O + (size_t)(rt * 64 + t) * 1024 + 512 + lane * 8) = w; }
    __syncthreads();
}

__device__ __forceinline__ void cg_load_row(const bf16_t* Gb, int rtx, int n_r, int cb, int tid, u32x4 (&vals)[5]) {
    const int cvf = tid & 31, sl = tid >> 5;
    const bool ctx = rtx < 128; const int q = rtx & 3;
#pragma unroll
    for (int i = 0; i < 5; ++i) {
        const int slot = sl + 16 * i, tok = slot - 1;
        bool ok = ctx ? ((tok >= 0 || q > 0) && (tok < 64 || q < 3)) : (tok >= 0 && tok < 64);
        if (i == 4 && sl >= 2) ok = false;
        vals[i] = (u32x4){0u, 0u, 0u, 0u};
        if (ok) vals[i] = __builtin_nontemporal_load((const u32x4*)(Gb + (size_t)((long)rtx * 64 + tok) * n_r + cb * 256 + cvf * 8));
    }
}
__device__ __forceinline__ void cg_store_row(bf16_t* Tl, int rtx, int tid, const u32x4 (&vals)[5]) {
    const int cvf = tid & 31, sl = tid >> 5; bf16_t* base = Tl + (size_t)(rtx % 3) * (66 * 256);
#pragma unroll
    for (int i = 0; i < 5; ++i) { const int slot = sl + 16 * i; if (i < 4 || sl < 2) *(u32x4*)(base + (size_t)slot * 256 + cvf * 8) = vals[i]; }
}
__device__ __forceinline__ void phase_convgate(CP& p, int l, int ntile, int n_r, int ch0, unsigned char* smem) {
    bf16_t* Tl = (bf16_t*)smem;
    const int tid = opaque_tid();
    const bf16_t* Gb = (const bf16_t*)(p.ws + WS_FG);
    bf16_t* Ab = (bf16_t*)(p.ws + WS_FA);
    const int G = gridDim.x, bid = blockIdx.x;
    const int cb = bid % ntile, idx = bid / ntile, nb = (G - cb + ntile - 1) / ntile, per = (384 + nb - 1) / nb;
    const int rt_lo = idx * per, rt_hi = (rt_lo + per < 384) ? rt_lo + per : 384;
    if (rt_lo >= rt_hi) return;
    const int cv = tid & 31, tg = tid >> 5;
    const int chl = cb * 256 + cv * 8, chg = ch0 + chl;
    const float* cw = p.in[I_FCW] + (size_t)l * 9 * DFF; const float* cbv = p.in[I_FCB] + l * DFF;
    f32x4 wt[9][2];
#pragma unroll
    for (int t9 = 0; t9 < 9; ++t9) { wt[t9][0] = *(const f32x4*)(cw + (size_t)t9 * DFF + chg); wt[t9][1] = *(const f32x4*)(cw + (size_t)t9 * DFF + chg + 4); }
    float bias[8];
    { const f32x4 b0 = *(const f32x4*)(cbv + chg), b1 = *(const f32x4*)(cbv + chg + 4); bias[0] = b0[0]; bias[1] = b0[1]; bias[2] = b0[2]; bias[3] = b0[3]; bias[4] = b1[0]; bias[5] = b1[1]; bias[6] = b1[2]; bias[7] = b1[3]; }
    {
        u32x4 v0[5], v1[5], v2[5];
        if (rt_lo > 0) cg_load_row(Gb, rt_lo - 1, n_r, cb, tid, v0);
        cg_load_row(Gb, rt_lo, n_r, cb, tid, v1);
        if (rt_lo + 1 < 384) cg_load_row(Gb, rt_lo + 1, n_r, cb, tid, v2);
        if (rt_lo > 0) cg_store_row(Tl, rt_lo - 1, tid, v0);
        cg_store_row(Tl, rt_lo, tid, v1);
        if (rt_lo + 1 < 384) cg_store_row(Tl, rt_lo + 1, tid, v2);
    }
    __syncthreads();
#pragma unroll 1
    for (int rt = rt_lo; rt < rt_hi; ++rt) {
        const bool ctx = rt < 128; const int gr = (rt - 128) & 63, r0 = rt * 64;
        const bool pre = (rt + 2 < 384) && (rt + 1 < rt_hi);
        u32x4 nx[5];
        if (pre) cg_load_row(Gb, rt + 2, n_r, cb, tid, nx);
        u32x4 av4[4];
#pragma unroll
        for (int tt = 0; tt < 4; ++tt) av4[tt] = __builtin_nontemporal_load((const u32x4*)(Ab + (size_t)(r0 + tg * 4 + tt) * n_r + chl));
        v2f acc[4][4];
#pragma unroll
        for (int tt = 0; tt < 4; ++tt)
#pragma unroll
            for (int e = 0; e < 4; ++e) acc[tt][e] = (v2f){bias[2 * e], bias[2 * e + 1]};
#pragma unroll
        for (int dy = 0; dy < 3; ++dy) {
            if (dy == 0 && (ctx || gr == 0)) continue;
            if (dy == 2 && (ctx || gr == 63)) continue;
            const bf16_t* rowb = Tl + (size_t)((rt + dy + 2) % 3) * (66 * 256);
#pragma unroll
            for (int dx = 0; dx < 3; ++dx) {
                const f32x4 w0 = wt[dy * 3 + dx][0], w1 = wt[dy * 3 + dx][1];
                const v2f wa = (v2f){w0[0], w0[1]}, wb = (v2f){w0[2], w0[3]}, wc2 = (v2f){w1[0], w1[1]}, wd = (v2f){w1[2], w1[3]};
#pragma unroll
                for (int tt = 0; tt < 4; ++tt) { const int col = tg * 4 + tt;
                    const u32x4 d = *(const u32x4*)(rowb + (size_t)(col + dx) * 256 + cv * 8);
                    acc[tt][0] += wa * (v2f){__uint_as_float(d.x << 16), __uint_as_float(d.x & 0xffff0000u)};
                    acc[tt][1] += wb * (v2f){__uint_as_float(d.y << 16), __uint_as_float(d.y & 0xffff0000u)};
                    acc[tt][2] += wc2 * (v2f){__uint_as_float(d.z << 16), __uint_as_float(d.z & 0xffff0000u)};
                    acc[tt][3] += wd * (v2f){__uint_as_float(d.w << 16), __uint_as_float(d.w & 0xffff0000u)}; }
            }
        }
#pragma unroll
        for (int tt = 0; tt < 4; ++tt) { const size_t off = (size_t)(r0 + tg * 4 + tt) * n_r + chl;
            const u32x4 a = av4[tt];
            float av[8]; unpack8(a, av);
            float hv[8];
#pragma unroll
            for (int e = 0; e < 8; ++e) hv[e] = gelu_fast(acc[tt][e >> 1][e & 1]) * av[e];
            u32x4 w; w.x = pk2(hv[0], hv[1]); w.y = pk2(hv[2], hv[3]); w.z = pk2(hv[4], hv[5]); w.w = pk2(hv[6], hv[7]);
            *(u32x4*)(Ab + off) = w; }
        __syncthreads();
        if (pre) cg_store_row(Tl, rt + 2, tid, nx);
        __syncthreads();
    }
}

#ifndef NO_MEGA
__global__ void __launch_bounds__(NTHR, 2) mega_fwd(P p) {
    extern __shared__ __attribute__((aligned(16))) unsigned char smem[];
    cg::grid_group grid = cg::this_grid();
    const int G = gridDim.x, bid = blockIdx.x;
    LAS unsigned char* lds = (LAS unsigned char*)smem;
    CP* kp = (CP*)__builtin_amdgcn_kernarg_segment_ptr();
    unsigned char* ws = p.ws;
#define PQ (*opq(kp))

    volatile LAS unsigned* bst = (volatile LAS unsigned*)(lds + LDS_BYTES - 16);
    if (threadIdx.x < 2) bst[threadIdx.x] = 0u;
    __syncthreads();
    const XcdBarrier xbar = xcd_barrier_post((unsigned*)(ws + WS_BAR), bst);
#define GSYNC() xcd_barrier(xbar)
#define MULT(k) (1 + ((PROBE_MASK >> (k)) & 1))
#define REP(k) _Pragma("unroll 1") for (int rep = (PROBE_MASK >> (k)) & 1; rep >= 0; --rep)
#ifndef SKIP_MASK
#define SKIP_MASK 0
#endif
#ifndef NRUN
#define NRUN 1
#endif
#pragma unroll 1
    for (int run = 0; run < NRUN; ++run) {
    const int skipm = (NRUN == 2 && run == 0) ? SKIP_MASK : 0;
#define SK(k) ((skipm >> (k)) & 1)
    if (!SK(0)) REP(0) {
        phase_mod(PQ, smem);
        __syncthreads();
        phase_h2(PQ, smem);
    }
    GSYNC();
    if (PQ.ws == nullptr) grid.sync();

#pragma unroll 1
    for (int l = 0; l < 2; ++l) {
        const float* MODl = (const float*)(ws + WS_MOD) + (size_t)l * 5 * 6144;
        if (!SK(1)) REP(1) phase_wconv(PQ, l, 0, l == 0 ? 896 : 0, bid, G, true, smem);
        if (!SK(2)) REP(2) phase_norm(PQ, l, 0);
        if (!SK(3)) REP(3) phase_taps(PQ, l, smem);
        GSYNC();
        if (!SK(4)) REP(4) {
            SchedWin S; S.init(96, 10, G, bid); S.XN = (const char*)(ws + WS_XN); S.W = (const char*)(ws + WS_WIN); S.tstep = (size_t)256 * 1024 * 2;
            EpiWin E{(bf16_t*)(ws + WS_PRG), (bf16_t*)(ws + WS_PHY)};
            pg8::gemm_phase(lds, 1024, S, E);
        }
        GSYNC();
        if (!SK(5)) for (int c = bid; c < 512 * MULT(5); c += G) hyena_item(PQ, l, c & 511, smem, MULT(5) == 2 && c < 512);
        __syncthreads();
        if (!SK(6)) for (int ci = bid; ci < 768 * MULT(6); ci += G) rg_item<1>(PQ, l, ci % 768, smem);
        GSYNC();
        if (!SK(7)) for (int ci = bid; ci < 768 * MULT(7); ci += G) rg_item<3>(PQ, l, ci % 768, smem);
        if (!SK(8)) for (int rt = bid; rt < 384 * MULT(8); rt += G) hytrans_item(PQ, l, rt % 384, smem);
        GSYNC();
        if (!SK(9)) REP(9) {
            SchedStd S; S.init(96, 4, G, bid); S.A = (const char*)(ws + WS_XN); S.B = (const char*)(ws + WS_WOUT); S.tstep = (size_t)256 * 1024 * 2;
            if (l == 0) { EpiResT<true> E; E.xin_ctx = p.in[I_XP]; E.xin_lat = p.in[I_XS] - (size_t)NCTX * 1024; E.xin_b = nullptr; E.out_b = (bf16_t*)p.out; E.gate = MODl + 2048; E.dry = rep == 1;
                pg8::gemm_phase(lds, 1024, S, E); }
            else { EpiResT<false> E; E.xin_ctx = nullptr; E.xin_lat = nullptr; E.xin_b = (const bf16_t*)p.out; E.out_b = (bf16_t*)p.out; E.gate = MODl + 2048; E.dry = rep == 1;
                pg8::gemm_phase(lds, 1024, S, E); }
        }
        const int idle_lo = (G < 384 && G >= 192) ? 384 - G : 0, nidle = G - idle_lo;
        if (bid >= idle_lo && !SK(1)) {
            phase_wconv(PQ, l, 896, 1664, bid - idle_lo, nidle, false, smem);
            phase_wconv(PQ, l, 2304, 2688, bid - idle_lo, nidle, false, smem);
        }
        GSYNC();
        if (!SK(10)) REP(10) phase_norm(PQ, l, 1);
        GSYNC();
#pragma unroll 1
        for (int r = 0; r < 2; ++r) {
            const int n_r = r ? FF_N1 : FF_N0, ntile = n_r / 256, ch0 = r ? FF_N0 : 0;
            if (!SK(11)) REP(11) {
                SchedStd S; S.init(96, 2 * ntile, G, bid); S.A = (const char*)(ws + WS_XN); S.B = (const char*)(ws + WS_WUP) + (r ? (size_t)3072 * 1024 * 2 : 0); S.tstep = (size_t)256 * 1024 * 2;
                EpiUp E{(bf16_t*)(ws + WS_FA), (bf16_t*)(ws + WS_FG), ntile, n_r};
                pg8::gemm_phase(lds, 1024, S, E);
            }
            GSYNC();
            if (!SK(12)) phase_convgate(PQ, l, ntile, n_r, ch0, smem);
            GSYNC();
            if (!SK(13)) REP(13) {
                SchedStd S; S.init(96, 4, G, bid); S.A = (const char*)(ws + WS_FA); S.B = (const char*)(ws + (r ? WS_WDN1 : WS_WDN0)); S.tstep = (size_t)256 * n_r * 2;
                EpiResT<false> E; E.xin_ctx = nullptr; E.xin_lat = nullptr; E.xin_b = (const bf16_t*)p.out;
                E.out_b = (l == 1 && r == 1) ? (bf16_t*)(ws + WS_XN) : (bf16_t*)p.out;
                E.gate = MODl + 5120; E.dry = rep == 1;
                pg8::gemm_phase(lds, n_r, S, E);
            }
            if (bid >= idle_lo && !SK(1)) {
                if (r == 0) { phase_wconv(PQ, l, 1664, 2304, bid - idle_lo, nidle, false, smem); phase_wconv(PQ, l, 2688, 3008, bid - idle_lo, nidle, false, smem); }
                else if (l == 0) phase_wconv(PQ, 1, 0, 896, bid - idle_lo, nidle, false, smem);
            }
            GSYNC();
        }
    }
#if PROBE_MASK
    if (PROBE_MASK & (1 << 15)) { for (int i = 0; i < 20; ++i) GSYNC(); }
#endif
    if (!SK(14)) phase_final_norm(PQ);
    if (NRUN == 2) GSYNC();
    }
#undef SK
#undef REP
#undef PQ
#undef GSYNC
#undef MULT
}

extern "C" void kernel_launch(void* const* d_in, const int* in_sizes, int n_in, void* d_out, int out_size, void* d_ws, size_t ws_size, hipStream_t stream) {
    static int grid = 0;
    if (grid == 0) {
        if (n_in != 32 || ws_size < WS_END) { fprintf(stderr, "kernel_launch: unexpected n_in %d or ws_size %zu (need %zu)\n", n_in, ws_size, (size_t)WS_END); grid = -1; return; }
        int dev = 0, cus = 0, per_cu = 0;
        (void)hipGetDevice(&dev);
        (void)hipDeviceGetAttribute(&cus, hipDeviceAttributeMultiprocessorCount, dev);
        if (hipFuncSetAttribute((const void*)mega_fwd, hipFuncAttributeMaxDynamicSharedMemorySize, LDS_BYTES) != hipSuccess) { fprintf(stderr, "kernel_launch: hipFuncSetAttribute failed\n"); grid = -1; return; }
        if (hipOccupancyMaxActiveBlocksPerMultiprocessor(&per_cu, (const void*)mega_fwd, NTHR, LDS_BYTES) != hipSuccess || per_cu < 1) { fprintf(stderr, "kernel_launch: occupancy query says %d blocks/CU\n", per_cu); per_cu = 1; }
        (void)hipGetLastError();
        grid = cus > 0 ? cus : 256;
    }
    if (grid < 0) return;
    P p{};
    for (int i = 0; i < 32; ++i) p.in[i] = (const float*)d_in[i];
    p.out = (float*)d_out; p.ws = (unsigned char*)d_ws; p.dup_mask = PROBE_MASK;
    (void)hipMemsetAsync((char*)d_ws + WS_BAR, 0, WS_BAR_BYTES, stream);
    void* args[] = {&p};
    hipError_t e = hipLaunchCooperativeKernel((const void*)mega_fwd, dim3(grid), dim3(NTHR), args, LDS_BYTES, stream);
    if (e != hipSuccess) fprintf(stderr, "kernel_launch: cooperative launch failed: %s (grid %d)\n", hipGetErrorString(e), grid);
}
#endif
```
